# Optimizing an MI355X kernel written in HIP

```python
import math
import jax, jax.numpy as jnp
from jax import lax
import numpy as np

D_MODEL = 1024
BATCH = 8
SEQ = 2048
DEPTH = 1

MLA_HEADS = 8
MLA_NOPE_DIM = 64
MLA_ROPE_DIM = 32
MLA_V_DIM = 64
MLA_QK_DIM = MLA_NOPE_DIM + MLA_ROPE_DIM
MLA_Q_RANK = 384
MLA_KV_RANK = 256
DIFF_HEADS = 4
DIFF_HEAD_DIM = 64
DIFF_V_DIM = 2 * DIFF_HEAD_DIM
MIX_WIDTH = MLA_HEADS * MLA_V_DIM + DIFF_HEADS * DIFF_V_DIM
IN_SPLITS = (MLA_Q_RANK, MLA_KV_RANK, MLA_ROPE_DIM,
             DIFF_HEADS * 2 * DIFF_HEAD_DIM,
             DIFF_HEADS * 2 * DIFF_HEAD_DIM,
             DIFF_HEADS * DIFF_V_DIM)
IN_COLS = sum(IN_SPLITS)
D_FF = 2816
CONV_WIDTH = 3
ROPE_THETA = 10000.0
NORM_EPS = 1e-6
Q_BLOCK = 128

kernel_name = "hybrid_mla_diffattn_convglu"


def rms_norm(x, g):
    xf = x.astype(jnp.float32)
    y = xf * lax.rsqrt(jnp.mean(xf * xf, axis=-1, keepdims=True) + NORM_EPS)
    return (y * g.astype(jnp.float32)).astype(x.dtype)


def rope_tables(seq, dim):
    inv = 1.0 / (ROPE_THETA ** (jnp.arange(0, dim, 2, dtype=jnp.float32) / dim))
    ang = jnp.arange(seq, dtype=jnp.float32)[:, None] * inv[None, :]
    return jnp.cos(ang), jnp.sin(ang)


def apply_rope(x, cos, sin):
    xf = x.astype(jnp.float32)
    half = xf.shape[-1] // 2
    x1, x2 = xf[..., :half], xf[..., half:]
    out = jnp.concatenate([x1 * cos - x2 * sin, x2 * cos + x1 * sin], axis=-1)
    return out.astype(x.dtype)


def causal_block_probs(q_blk, k_pre, scale, q_start):
    s = jnp.einsum('bhqd,bhkd->bhqk', q_blk, k_pre).astype(jnp.float32) * scale
    q_pos = q_start + jnp.arange(q_blk.shape[2])
    k_pos = jnp.arange(k_pre.shape[2])
    mask = k_pos[None, :] <= q_pos[:, None]
    s = jnp.where(mask, s, -jnp.inf)
    return jax.nn.softmax(s, axis=-1)


def mla_attention(q, k, v, scale):
    seq = q.shape[2]
    outs = []
    for i in range(seq // Q_BLOCK):
        s0, e = i * Q_BLOCK, (i + 1) * Q_BLOCK
        p = causal_block_probs(q[:, :, s0:e], k[:, :, :e], scale, s0)
        outs.append(jnp.einsum('bhqk,bhkd->bhqd', p.astype(v.dtype), v[:, :, :e]))
    return jnp.concatenate(outs, axis=2)


def differential_attention(q1, q2, k1, k2, v, lam, scale):
    seq = q1.shape[2]
    outs = []
    for i in range(seq // Q_BLOCK):
        s0, e = i * Q_BLOCK, (i + 1) * Q_BLOCK
        p1 = causal_block_probs(q1[:, :, s0:e], k1[:, :, :e], scale, s0)
        p2 = causal_block_probs(q2[:, :, s0:e], k2[:, :, :e], scale, s0)
        w = (p1 - lam * p2).astype(v.dtype)
        outs.append(jnp.einsum('bhqk,bhkd->bhqd', w, v[:, :, :e]))
    return jnp.concatenate(outs, axis=2)


def causal_depthwise_conv(x, w, b):
    seq = x.shape[1]
    xp = jnp.pad(x, ((0, 0), (CONV_WIDTH - 1, 0), (0, 0)))
    out = b
    for j in range(CONV_WIDTH):
        out = out + xp[:, j:j + seq] * w[j]
    return out


def setup_inputs(seed: int = 0) -> dict:
    key = jax.random.key(seed)
    ks = jax.random.split(key, 24)
    L = DEPTH

    def nrm(k, shape, fan_in):
        return jax.random.normal(k, shape, jnp.float32) * (fan_in ** -0.5)

    def gain(k, shape):
        return 1.0 + 0.02 * jax.random.normal(k, shape, jnp.float32)

    return {
        "x": jax.random.normal(ks[0], (BATCH, SEQ, D_MODEL), jnp.float32),
        "attn_norm_g": gain(ks[1], (L, D_MODEL)),
        "w_in": nrm(ks[2], (L, D_MODEL, IN_COLS), D_MODEL),
        "q_a_norm_g": gain(ks[3], (L, MLA_Q_RANK)),
        "w_q_up": nrm(ks[4], (L, MLA_Q_RANK, MLA_HEADS * MLA_QK_DIM), MLA_Q_RANK),
        "kv_a_norm_g": gain(ks[5], (L, MLA_KV_RANK)),
        "w_kv_up": nrm(ks[6], (L, MLA_KV_RANK, MLA_HEADS * (MLA_NOPE_DIM + MLA_V_DIM)), MLA_KV_RANK),
        "mla_q_norm_g": gain(ks[7], (L, MLA_QK_DIM)),
        "mla_k_norm_g": gain(ks[8], (L, MLA_QK_DIM)),
        "diff_q_norm_g": gain(ks[9], (L, DIFF_HEAD_DIM)),
        "diff_k_norm_g": gain(ks[10], (L, DIFF_HEAD_DIM)),
        "lambda_q1": 0.1 * jax.random.normal(ks[11], (L, DIFF_HEAD_DIM), jnp.float32),
        "lambda_k1": 0.1 * jax.random.normal(ks[12], (L, DIFF_HEAD_DIM), jnp.float32),
        "lambda_q2": 0.1 * jax.random.normal(ks[13], (L, DIFF_HEAD_DIM), jnp.float32),
        "lambda_k2": 0.1 * jax.random.normal(ks[14], (L, DIFF_HEAD_DIM), jnp.float32),
        "diff_subln_g": gain(ks[15], (L, DIFF_V_DIM)),
        "w_out": nrm(ks[16], (L, MIX_WIDTH, D_MODEL), MIX_WIDTH),
        "ffn_norm_g": gain(ks[17], (L, D_MODEL)),
        "w_gate": nrm(ks[18], (L, D_MODEL, D_FF), D_MODEL),
        "w_up": nrm(ks[19], (L, D_MODEL, D_FF), D_MODEL),
        "conv_w": nrm(ks[20], (L, CONV_WIDTH, D_FF), CONV_WIDTH),
        "conv_b": 0.02 * jax.random.normal(ks[21], (L, D_FF), jnp.float32),
        "w_down": nrm(ks[22], (L, D_FF, D_MODEL), D_FF),
    }


def reference(x, attn_norm_g, w_in, q_a_norm_g, w_q_up, kv_a_norm_g, w_kv_up,
              mla_q_norm_g, mla_k_norm_g, diff_q_norm_g, diff_k_norm_g,
              lambda_q1, lambda_k1, lambda_q2, lambda_k2, diff_subln_g, w_out,
              ffn_norm_g, w_gate, w_up, conv_w, conv_b, w_down):
    B, S, _ = x.shape
    cos_a, sin_a = rope_tables(S, MLA_ROPE_DIM)
    cos_b, sin_b = rope_tables(S, DIFF_HEAD_DIM)
    split_idx = []
    acc = 0
    for n in IN_SPLITS[:-1]:
        acc += n
        split_idx.append(acc)
    mla_scale = MLA_QK_DIM ** -0.5
    diff_scale = DIFF_HEAD_DIM ** -0.5

    for l in range(DEPTH):
        h = rms_norm(x, attn_norm_g[l])
        proj = h @ w_in[l]
        cq, ckv, kpe, dq, dk, dv = jnp.split(proj, split_idx, axis=-1)

        q = (rms_norm(cq, q_a_norm_g[l]) @ w_q_up[l]).reshape(B, S, MLA_HEADS, MLA_QK_DIM)
        kv = (rms_norm(ckv, kv_a_norm_g[l]) @ w_kv_up[l]).reshape(B, S, MLA_HEADS, MLA_NOPE_DIM + MLA_V_DIM)
        k_nope, v_a = kv[..., :MLA_NOPE_DIM], kv[..., MLA_NOPE_DIM:]
        gq, gk = mla_q_norm_g[l], mla_k_norm_g[l]
        q_nope = rms_norm(q[..., :MLA_NOPE_DIM], gq[:MLA_NOPE_DIM]).transpose(0, 2, 1, 3)
        q_pe = rms_norm(q[..., MLA_NOPE_DIM:], gq[MLA_NOPE_DIM:]).transpose(0, 2, 1, 3)
        k_nope = rms_norm(k_nope, gk[:MLA_NOPE_DIM]).transpose(0, 2, 1, 3)
        k_pe = rms_norm(kpe, gk[MLA_NOPE_DIM:])[:, None]
        q_pe = apply_rope(q_pe, cos_a, sin_a)
        k_pe = apply_rope(k_pe, cos_a, sin_a)
        q_a = jnp.concatenate([q_nope, q_pe], axis=-1)
        k_a = jnp.concatenate([k_nope, jnp.broadcast_to(k_pe, (B, MLA_HEADS, S, MLA_ROPE_DIM))], axis=-1)
        o_a = mla_attention(q_a, k_a, v_a.transpose(0, 2, 1, 3), mla_scale)
        o_a = o_a.transpose(0, 2, 1, 3).reshape(B, S, MLA_HEADS * MLA_V_DIM)

        dq = rms_norm(dq.reshape(B, S, DIFF_HEADS, 2, DIFF_HEAD_DIM), diff_q_norm_g[l])
        dk = rms_norm(dk.reshape(B, S, DIFF_HEADS, 2, DIFF_HEAD_DIM), diff_k_norm_g[l])
        dq = apply_rope(dq.transpose(0, 2, 3, 1, 4), cos_b, sin_b)
        dk = apply_rope(dk.transpose(0, 2, 3, 1, 4), cos_b, sin_b)
        v_b = dv.reshape(B, S, DIFF_HEADS, DIFF_V_DIM).transpose(0, 2, 1, 3)
        lam_init = 0.8 - 0.6 * math.exp(-0.3 * l)
        lam = (jnp.exp(jnp.sum(lambda_q1[l].astype(jnp.float32) * lambda_k1[l].astype(jnp.float32)))
               - jnp.exp(jnp.sum(lambda_q2[l].astype(jnp.float32) * lambda_k2[l].astype(jnp.float32)))
               + lam_init)
        o_b = differential_attention(dq[:, :, 0], dq[:, :, 1], dk[:, :, 0], dk[:, :, 1], v_b, lam, diff_scale)
        o_b = rms_norm(o_b, diff_subln_g[l]) * (1.0 - lam_init)
        o_b = o_b.transpose(0, 2, 1, 3).reshape(B, S, DIFF_HEADS * DIFF_V_DIM)

        mix = jnp.concatenate([o_a, o_b], axis=-1) @ w_out[l]
        x = x + mix

        h = rms_norm(x, ffn_norm_g[l])
        g = causal_depthwise_conv(h @ w_gate[l], conv_w[l], conv_b[l])
        u = h @ w_up[l]
        x = x + (jax.nn.silu(g) * u) @ w_down[l]
    return x
```

```cpp
#include <hip/hip_runtime.h>
#include <hip/hip_cooperative_groups.h>
#include <cstdio>
#include <cstdint>
#include <cmath>
namespace cg = cooperative_groups;

constexpr int BATCH = 8, SEQ = 2048, DM = 1024, M = BATCH * SEQ;
constexpr int FF = 2816;
constexpr float EPS = 1e-6f;
constexpr float LOG2E = 1.4426950408889634f;
constexpr float QSCALE_A = 0.10206207261596577f * LOG2E;
constexpr float QSCALE_D = 0.125f * LOG2E;

__device__ __forceinline__ int lane_fresh() { int l; asm volatile("v_mbcnt_lo_u32_b32 %0, -1, 0\n\tv_mbcnt_hi_u32_b32 %0, -1, %0" : "=v"(l)); return l; }
__device__ __forceinline__ float shx(float v, int mask) { const int idx = (lane_fresh() ^ mask) << 2; return __builtin_bit_cast(float, __builtin_amdgcn_ds_bpermute(idx, __builtin_bit_cast(int, v))); }
__device__ __forceinline__ float shl(float v, int src) { return __builtin_bit_cast(float, __builtin_amdgcn_ds_bpermute(src << 2, __builtin_bit_cast(int, v))); }
namespace pg8 {
#define PG8_LAS __attribute__((address_space(3)))
typedef unsigned short bf16_t;
typedef short bf16x8 __attribute__((ext_vector_type(8)));
typedef float f32x4 __attribute__((ext_vector_type(4)));
typedef unsigned u32x4 __attribute__((ext_vector_type(4)));
constexpr int BM = 256, BK = 64, HALF = 128, HTB = HALF * BK * 2  , STAGE_BYTES = 8 * HTB, NXCD = 8, WGM = 8;

__host__ __device__ __forceinline__ int lds_byte(int r, int c) { const int st = (r >> 4) * 2 + (c >> 5), rr = r & 15, cc = c & 31, ob = rr * 64 + cc * 2; return st * 1024 + (ob ^ (((ob >> 9) & 1) << 5)); }
__host__ __device__ __forceinline__ void stage_rc(int b, int& R, int& C) { const int st = b / 1024, sb = b % 1024, swz = sb ^ (((sb >> 9) & 1) << 5); R = (st >> 1) * 16 + swz / 64; C = (st & 1) * 32 + (swz % 64) / 2; }
__host__ __device__ __forceinline__ int perm32(int rho) { const int n = rho >> 4, i = rho & 15; return 8 * (i >> 2) + 4 * n + (i & 3); }

struct Unit { int pm, pn; };
struct Gemm { const bf16_t* A; const bf16_t* Bt; int M, N, K; };

struct StaticOrder {
    int nM, nN, nwg, G, c;
    __host__ __device__ void init(int M, int N, int G_, int c_) { nM = M / BM; nN = N / BM; nwg = nM * nN; G = G_; c = c_; }
    __host__ __device__ bool next(int i, Unit& u) const {
        const long L = (long)i * G + c; if (L >= nwg) return false;
        int wgid = (int)L; { const int q = nwg / NXCD, r = nwg % NXCD, xcd = wgid % NXCD, off = wgid / NXCD; wgid = (xcd < r ? xcd * (q + 1) : r * (q + 1) + (xcd - r) * q) + off; }
        const int nig = WGM * nN, gid = wgid / nig, fm = gid * WGM, gsz = (nM - fm) < WGM ? (nM - fm) : WGM;
        u.pm = fm + ((wgid % nig) % gsz); u.pn = (wgid % nig) / gsz; return true;
    }
    __device__ __forceinline__ void a_ready(const Unit&) const {}
    __device__ __forceinline__ void done(const Unit&) const {}
};

typedef unsigned u32x2 __attribute__((ext_vector_type(2)));
typedef float f32x2 __attribute__((ext_vector_type(2)));
typedef __bf16 bf16x2_t __attribute__((ext_vector_type(2)));
__device__ __forceinline__ unsigned cvt_pk_bf16(float lo, float hi) { f32x2 v = {lo, hi}; bf16x2_t b = __builtin_convertvector(v, bf16x2_t); return __builtin_bit_cast(unsigned, b); }
__device__ __forceinline__ u32x2 pack4(f32x4 v) { u32x2 w; w.x = cvt_pk_bf16(v[0], v[1]); w.y = cvt_pk_bf16(v[2], v[3]); return w; }
__device__ __forceinline__ void store8(bf16_t* p, u32x2 w) { *(u32x2*)p = w; }
__device__ __forceinline__ void store8_wt(bf16_t* p, u32x2 w) { __hip_atomic_store((unsigned long long*)p, (unsigned long long)w.x | ((unsigned long long)w.y << 32), __ATOMIC_RELAXED, __HIP_MEMORY_SCOPE_AGENT); }
__device__ __forceinline__ float dot4(f32x4 v) { return (v[0] * v[0] + v[1] * v[1]) + (v[2] * v[2] + v[3] * v[3]); }
__device__ __forceinline__ float red_fq(float s) { s += shx(s, 16); s += shx(s, 32); return s; }
constexpr float EPSN = 1e-6f;

struct EpiInProj {
    static constexpr bool PERM = false, AFTER_DRAIN = false, INIT = false;
    bf16_t *CQ, *CKV, *Kpe, *Qd, *Kd; float *ssq_q; const float *gk, *gdq, *gdk; const float* ropeA; const float* ropeB; float qscale_d; PG8_LAS float* part; unsigned* cntq; unsigned* cntkv;
    __device__ __forceinline__ void operator()(const f32x4 (&acc)[2][2][4][2], const Unit& u, int wr, int wc, int fr, int fq) const {
        asm volatile("" : "+v"(fr), "+v"(fq));
        const int pn = u.pn;
        if (pn == 2) {
#pragma unroll
            for (int ai = 0; ai < 2; ++ai)
#pragma unroll
                for (int m = 0; m < 4; ++m) {
                    float ss = 0.f;
#pragma unroll
                    for (int bj = 0; bj < 2; ++bj)
#pragma unroll
                        for (int n = 0; n < 2; ++n) ss += dot4(acc[ai][bj][m][n]);
                    ss = red_fq(ss);
                    if (fq == 0) part[(ai * HALF + wr * 64 + m * 16 + fr) * 4 + wc] = ss;
                }
            asm volatile("s_waitcnt lgkmcnt(0)" ::: "memory"); __builtin_amdgcn_s_barrier(); asm volatile("" ::: "memory");
#pragma unroll
            for (int ai = 0; ai < 2; ++ai)
#pragma unroll
                for (int m = 0; m < 4; ++m) {
                    const int rl = ai * HALF + wr * 64 + m * 16 + fr, row = u.pm * BM + rl;
                    const f32x4 q = *(const PG8_LAS f32x4*)(part + rl * 4);
                    const float rstd = rsqrtf(((q[0] + q[1]) + (q[2] + q[3])) * (1.f / 256.f) + EPSN);
                    bf16_t* dst = CKV + (size_t)row * 256 + 64 * wc;
#pragma unroll
                    for (int bj = 0; bj < 2; ++bj)
#pragma unroll
                        for (int n = 0; n < 2; ++n) store8_wt(dst + 32 * bj + 16 * n + 4 * fq, pack4(acc[ai][bj][m][n] * rstd));
                }
            asm volatile("s_waitcnt vmcnt(0)" ::: "memory");
            if (fr == 0 && fq == 0) __hip_atomic_fetch_add(cntkv + 64 * u.pm, 1u, __ATOMIC_RELAXED, __HIP_MEMORY_SCOPE_AGENT);
            return;
        }
#pragma unroll
        for (int ai = 0; ai < 2; ++ai)
#pragma unroll
            for (int m = 0; m < 4; ++m) {
                const int row = u.pm * BM + ai * HALF + wr * 64 + m * 16 + fr;
                if (pn < 2) {
                    if (pn != 1 || wc < 2) {
                        bf16_t* dst = CQ + (size_t)row * 384 + pn * 256 + 64 * wc;
                        float ss = 0.f;
#pragma unroll
                        for (int bj = 0; bj < 2; ++bj)
#pragma unroll
                            for (int n = 0; n < 2; ++n) { const f32x4 v = acc[ai][bj][m][n]; ss += dot4(v); store8_wt(dst + 32 * bj + 16 * n + 4 * fq, pack4(v)); }
                        ss = red_fq(ss);
                        if (fq == 0) __hip_atomic_store(ssq_q + (size_t)row * 8 + pn * 4 + wc, ss, __ATOMIC_RELAXED, __HIP_MEMORY_SCOPE_AGENT);
                    } else if (wc == 2) {
                        const f32x4 v0 = acc[ai][0][m][0], v1 = acc[ai][0][m][1];
                        float ss = red_fq(dot4(v0) + dot4(v1));
                        const float rstd = rsqrtf(ss * (1.f / 32.f) + EPSN);
                        const int s = row & (SEQ - 1);
                        const f32x4 g0 = *(const f32x4*)(gk + 64 + 4 * fq), g1 = *(const f32x4*)(gk + 80 + 4 * fq);
                        const f32x4 r0 = *(const f32x4*)(ropeA + (size_t)(s * 16 + 4 * fq) * 2), r1 = *(const f32x4*)(ropeA + (size_t)(s * 16 + 4 * fq) * 2 + 4);
                        const float cs[4] = {r0[0], r0[2], r1[0], r1[2]}, sn[4] = {r0[1], r0[3], r1[1], r1[3]};
                        f32x4 o1, o2;
#pragma unroll
                        for (int j = 0; j < 4; ++j) { const float x1 = v0[j] * rstd * g0[j], x2 = v1[j] * rstd * g1[j]; o1[j] = x1 * cs[j] - x2 * sn[j]; o2[j] = x2 * cs[j] + x1 * sn[j]; }
                        const u32x2 w1 = pack4(o1), w2 = pack4(o2);
                        store8(Kpe + (size_t)row * 32 + 4 * fq, w1); store8(Kpe + (size_t)row * 32 + 16 + 4 * fq, w2);
                    }
                } else {
                    const bool isq = pn < 5;
                    const int G8 = ((pn - 3) & 1) * 4 + wc;
                    const float* g = isq ? gdq : gdk;
                    bf16_t* dst = (isq ? Qd : Kd) + (size_t)row * 512 + G8 * 64;
                    float ss = 0.f;
#pragma unroll
                    for (int bj = 0; bj < 2; ++bj)
#pragma unroll
                        for (int n = 0; n < 2; ++n) ss += dot4(acc[ai][bj][m][n]);
                    ss = red_fq(ss);
                    const float rstd = rsqrtf(ss * (1.f / 64.f) + EPSN) * (isq ? qscale_d : 1.f);
                    const int s = row & (SEQ - 1);
#pragma unroll
                    for (int n = 0; n < 2; ++n) {
                        const int i0 = 16 * n + 4 * fq;
                        const f32x4 g0 = *(const f32x4*)(g + i0), g1 = *(const f32x4*)(g + 32 + i0);
                        const f32x4 r0 = *(const f32x4*)(ropeB + (size_t)(s * 32 + i0) * 2), r1 = *(const f32x4*)(ropeB + (size_t)(s * 32 + i0) * 2 + 4);
                        const float cs[4] = {r0[0], r0[2], r1[0], r1[2]}, sn[4] = {r0[1], r0[3], r1[1], r1[3]};
                        const f32x4 v0 = acc[ai][0][m][n], v1 = acc[ai][1][m][n];
                        f32x4 o1, o2;
#pragma unroll
                        for (int j = 0; j < 4; ++j) { const float x1 = v0[j] * rstd * g0[j], x2 = v1[j] * rstd * g1[j]; o1[j] = x1 * cs[j] - x2 * sn[j]; o2[j] = x2 * cs[j] + x1 * sn[j]; }
                        store8(dst + i0, pack4(o1)); store8(dst + 32 + i0, pack4(o2));
                    }
                }
            }
        if (pn < 2) {
            asm volatile("s_waitcnt vmcnt(0)" ::: "memory");
            if (fr == 0 && fq == 0) __hip_atomic_fetch_add(cntq + 64 * u.pm, 1u, __ATOMIC_RELAXED, __HIP_MEMORY_SCOPE_AGENT);
        }
    }
};

struct EpiStoreT {
    static constexpr bool PERM = false, AFTER_DRAIN = false, INIT = false;
    bf16_t* O; int ldo;
    __device__ __forceinline__ void operator()(const f32x4 (&acc)[2][2][4][2], const Unit& u, int wr, int wc, int fr, int fq) const {
        asm volatile("" : "+v"(fr), "+v"(fq));
        const int tok0 = u.pn * BM + wc * 32 + 4 * fq;
#pragma unroll
        for (int ai = 0; ai < 2; ++ai)
#pragma unroll
            for (int m = 0; m < 4; ++m) {
                const int row = u.pm * BM + ai * HALF + wr * 64 + m * 16 + fr;
                bf16_t* rp = O + (size_t)row * ldo + tok0;
#pragma unroll
                for (int bj = 0; bj < 2; ++bj)
#pragma unroll
                    for (int n = 0; n < 2; ++n) store8(rp + bj * HALF + n * 16, pack4(acc[ai][bj][m][n]));
            }
    }
};

struct EpiQUp {
    static constexpr bool PERM = false, AFTER_DRAIN = false, INIT = false;
    bf16_t* Qa; const float* ssq_q; const float* gq; const float* ropeA; float qscale;
    __device__ __forceinline__ void operator()(const f32x4 (&acc)[2][2][4][2], const Unit& u, int wr, int wc, int fr, int fq) const {
        asm volatile("" : "+v"(fr), "+v"(fq));
        const int ws = 4 * u.pn + wc;
#pragma unroll
        for (int ai = 0; ai < 2; ++ai)
#pragma unroll
            for (int m = 0; m < 4; ++m) {
                const int row = u.pm * BM + ai * HALF + wr * 64 + m * 16 + fr;
                float sq = 0.f; if (fq < 3) { const f32x2 qa = *(const f32x2*)(ssq_q + (size_t)row * 8 + 2 * fq); sq = qa[0] + qa[1]; }
                const float rstd_a = rsqrtf(red_fq(sq) * (1.f / 384.f) + EPSN);
                if (ws < 8) {
                    float ss = 0.f;
#pragma unroll
                    for (int bj = 0; bj < 2; ++bj)
#pragma unroll
                        for (int n = 0; n < 2; ++n) ss += dot4(acc[ai][bj][m][n] * rstd_a);
                    ss = red_fq(ss);
                    const float r2 = rsqrtf(ss * (1.f / 64.f) + EPSN) * qscale * rstd_a;
                    bf16_t* dst = Qa + (size_t)row * 768 + ws * 96;
#pragma unroll
                    for (int bj = 0; bj < 2; ++bj)
#pragma unroll
                        for (int n = 0; n < 2; ++n) { const int d0 = 32 * bj + 16 * n + 4 * fq; const f32x4 g = *(const f32x4*)(gq + d0); store8(dst + d0, pack4(acc[ai][bj][m][n] * g * r2)); }
                } else {
                    const int s = row & (SEQ - 1);
                    const f32x4 g0 = *(const f32x4*)(gq + 64 + 4 * fq), g1 = *(const f32x4*)(gq + 80 + 4 * fq);
                    const f32x4 r0 = *(const f32x4*)(ropeA + (size_t)(s * 16 + 4 * fq) * 2), r1 = *(const f32x4*)(ropeA + (size_t)(s * 16 + 4 * fq) * 2 + 4);
                    const float cs[4] = {r0[0], r0[2], r1[0], r1[2]}, sn[4] = {r0[1], r0[3], r1[1], r1[3]};
#pragma unroll
                    for (int bj = 0; bj < 2; ++bj) {
                        const int h = 2 * (ws - 8) + bj;
                        const f32x4 v0 = acc[ai][bj][m][0] * rstd_a, v1 = acc[ai][bj][m][1] * rstd_a;
                        const float ss = red_fq(dot4(v0) + dot4(v1));
                        const float r2 = rsqrtf(ss * (1.f / 32.f) + EPSN);
                        f32x4 o1, o2;
#pragma unroll
                        for (int j = 0; j < 4; ++j) { const float x1 = v0[j] * r2 * g0[j], x2 = v1[j] * r2 * g1[j]; o1[j] = (x1 * cs[j] - x2 * sn[j]) * qscale; o2[j] = (x2 * cs[j] + x1 * sn[j]) * qscale; }
                        bf16_t* dst = Qa + (size_t)row * 768 + h * 96 + 64 + 4 * fq;
                        store8(dst, pack4(o1)); store8(dst + 16, pack4(o2));
                    }
                }
                asm volatile("" ::: "memory");
            }
    }
};

struct EpiKUp {
    static constexpr bool PERM = false, AFTER_DRAIN = false, INIT = false;
    bf16_t* Ka; const float* gk;
    __device__ __forceinline__ void operator()(const f32x4 (&acc)[2][2][4][2], const Unit& u, int wr, int wc, int fr, int fq) const {
        asm volatile("" : "+v"(fr), "+v"(fq));
        const int h = 4 * u.pn + wc;
#pragma unroll
        for (int ai = 0; ai < 2; ++ai)
#pragma unroll
            for (int m = 0; m < 4; ++m) {
                const int row = u.pm * BM + ai * HALF + wr * 64 + m * 16 + fr;
                float ss = 0.f;
#pragma unroll
                for (int bj = 0; bj < 2; ++bj)
#pragma unroll
                    for (int n = 0; n < 2; ++n) ss += dot4(acc[ai][bj][m][n]);
                ss = red_fq(ss);
                const float r2 = rsqrtf(ss * (1.f / 64.f) + EPSN);
                bf16_t* dst = Ka + (size_t)row * 512 + h * 64;
#pragma unroll
                for (int bj = 0; bj < 2; ++bj)
#pragma unroll
                    for (int n = 0; n < 2; ++n) { const int d0 = 32 * bj + 16 * n + 4 * fq; const f32x4 g = *(const f32x4*)(gk + d0); store8(dst + d0, pack4(acc[ai][bj][m][n] * g * r2)); }
            }
    }
};

struct EpiWOut {
    static constexpr bool PERM = false, AFTER_DRAIN = false, INIT = true;
    const float* x; float* out; bf16_t* X1b; float* ssq_x1;
    __device__ __forceinline__ void init(f32x4 (&acc)[2][2][4][2], const Unit& u, int wr, int wc, int fr, int fq) const {
        const int col0 = u.pn * BM + wc * 32 + 4 * fq;
#pragma unroll
        for (int ai = 0; ai < 2; ++ai)
#pragma unroll
            for (int m = 0; m < 4; ++m) {
                const size_t off = (size_t)(u.pm * BM + ai * HALF + wr * 64 + m * 16 + fr) * DM + col0;
#pragma unroll
                for (int bj = 0; bj < 2; ++bj)
#pragma unroll
                    for (int n = 0; n < 2; ++n) acc[ai][bj][m][n] = *(const f32x4*)(x + off + bj * HALF + n * 16);
            }
    }
    __device__ __forceinline__ void operator()(const f32x4 (&acc)[2][2][4][2], const Unit& u, int wr, int wc, int fr, int fq) const {
        asm volatile("" : "+v"(fr), "+v"(fq));
        const int col0 = u.pn * BM + wc * 32 + 4 * fq;
#pragma unroll
        for (int ai = 0; ai < 2; ++ai)
#pragma unroll
            for (int m = 0; m < 4; ++m) {
                const int row = u.pm * BM + ai * HALF + wr * 64 + m * 16 + fr;
                const size_t off = (size_t)row * DM + col0;
                float ss = 0.f;
#pragma unroll
                for (int bj = 0; bj < 2; ++bj)
#pragma unroll
                    for (int n = 0; n < 2; ++n) {
                        const size_t o = off + bj * HALF + n * 16;
                        const f32x4 v = acc[ai][bj][m][n];
                        *(f32x4*)(out + o) = v; store8(X1b + o, pack4(v)); ss += dot4(v);
                    }
                ss = red_fq(ss);
                if (fq == 0) ssq_x1[(size_t)row * 16 + u.pn * 4 + wc] = ss;
            }
    }
};

struct EpiGateUp {
    static constexpr bool PERM = false, AFTER_DRAIN = false, INIT = false;
    bf16_t* A; float* HL; const float* ssq_x1; const float* conv_w; const float* conv_b;
    __device__ __forceinline__ void operator()(f32x4 (&acc)[2][2][4][2], const Unit& u, int wr, int wc, int fr, int fq) const {
        asm volatile("" : "+v"(fr), "+v"(fq));
        const int lane = fq * 16 + fr;
        const int src1 = (lane & ~15) | ((fr + 15) & 15), src2 = (lane & ~15) | ((fr + 14) & 15);
#pragma unroll
        for (int ai = 0; ai < 2; ++ai)
#pragma unroll
            for (int m = 0; m < 4; ++m) {
                const int row = u.pm * BM + ai * HALF + wr * 64 + m * 16 + fr;
                const f32x4 a = *(const f32x4*)(ssq_x1 + (size_t)row * 16 + 4 * fq);
                const float rs = rsqrtf(red_fq((a[0] + a[1]) + (a[2] + a[3])) * (1.f / 1024.f) + EPSN);
#pragma unroll
                for (int bj = 0; bj < 2; ++bj)
#pragma unroll
                    for (int n = 0; n < 2; ++n) acc[ai][bj][m][n] *= rs;
            }
#pragma unroll
        for (int n = 0; n < 2; ++n) {
            const int f = u.pn * 128 + wc * 32 + 16 * n + 4 * fq;
            const f32x4 w0 = *(const f32x4*)(conv_w + f), w1 = *(const f32x4*)(conv_w + FF + f), w2 = *(const f32x4*)(conv_w + 2 * FF + f), cb = *(const f32x4*)(conv_b + f);
#pragma unroll
            for (int ai = 0; ai < 2; ++ai) {
                f32x4 gprev = (f32x4){0.f, 0.f, 0.f, 0.f};
                const int kb = u.pm * 4 + ai * 2 + wr;
#pragma unroll
                for (int m = 0; m < 4; ++m) {
                    const int row = u.pm * BM + ai * HALF + wr * 64 + m * 16 + fr;
                    const f32x4 gc = acc[ai][0][m][n], uc = acc[ai][1][m][n];
                    f32x4 o;
#pragma unroll
                    for (int j = 0; j < 4; ++j) {
                        const float y1 = (fr == 15) ? gprev[j] : gc[j], y2 = (fr >= 14) ? gprev[j] : gc[j];
                        const float g1 = shl(y1, src1), g2 = shl(y2, src2);
                        const float cv = w2[j] * gc[j] + w1[j] * g1 + w0[j] * g2 + cb[j];
                        o[j] = cv / (1.f + __expf(-cv)) * uc[j];
                    }
                    if (m != 0 || fr >= 2) store8(A + (size_t)row * FF + f, pack4(o));
                    if (m == 0 && fr < 2) { *(f32x4*)(HL + ((size_t)kb * 6 + 2 + fr) * FF + f) = gc; *(f32x4*)(HL + ((size_t)kb * 6 + 4 + fr) * FF + f) = uc; }
                    if (m == 3 && fr >= 14) *(f32x4*)(HL + ((size_t)kb * 6 + (fr - 14)) * FF + f) = gc;
                    gprev = gc;
                }
            }
        }
    }
};

struct EpiDown {
    static constexpr bool PERM = false, AFTER_DRAIN = false, INIT = true;
    const float* src; float* out;
    __device__ __forceinline__ void init(f32x4 (&acc)[2][2][4][2], const Unit& u, int wr, int wc, int fr, int fq) const {
        const int col0 = u.pn * BM + wc * 32 + 4 * fq;
#pragma unroll
        for (int ai = 0; ai < 2; ++ai)
#pragma unroll
            for (int m = 0; m < 4; ++m) {
                const size_t off = (size_t)(u.pm * BM + ai * HALF + wr * 64 + m * 16 + fr) * DM + col0;
#pragma unroll
                for (int bj = 0; bj < 2; ++bj)
#pragma unroll
                    for (int n = 0; n < 2; ++n) acc[ai][bj][m][n] = *(const f32x4*)(src + off + bj * HALF + n * 16);
            }
    }
    __device__ __forceinline__ void operator()(const f32x4 (&acc)[2][2][4][2], const Unit& u, int wr, int wc, int fr, int fq) const {
        asm volatile("" : "+v"(fr), "+v"(fq));
        const int col0 = u.pn * BM + wc * 32 + 4 * fq;
#pragma unroll
        for (int ai = 0; ai < 2; ++ai)
#pragma unroll
            for (int m = 0; m < 4; ++m) {
                const size_t off = (size_t)(u.pm * BM + ai * HALF + wr * 64 + m * 16 + fr) * DM + col0;
#pragma unroll
                for (int bj = 0; bj < 2; ++bj)
#pragma unroll
                    for (int n = 0; n < 2; ++n) *(f32x4*)(out + off + bj * HALF + n * 16) = acc[ai][bj][m][n];
            }
    }
};

template <class Epi, class Sched, bool ALIGN_EPI = false, bool SP2 = false>
__device__ __forceinline__ void gemm_phase(PG8_LAS unsigned char* lds, const Gemm g, const Sched& S, const Epi& E, const int wave_s) {
    int tid_ = wave_s * 64 + lane_fresh(); asm volatile("" : "+v"(tid_));
    const int tid = tid_, wid = __builtin_amdgcn_readfirstlane(tid >> 6), lane = tid & 63, wr = wid >> 2, wc = wid & 3, fr = lane & 15, fq = lane >> 4;
    const int K = g.K, nt = K / BK;
    unsigned voffA[2], voffB[2];
#pragma unroll
    for (int i = 0; i < 2; ++i) { int R, C; stage_rc(tid * 16 + i * 8192, R, C); const int Rb = Epi::PERM ? ((R & ~31) + perm32(R & 31)) : R;
        voffA[i] = (unsigned)(R * K + C) * 2u; voffB[i] = (unsigned)(Rb * K + C) * 2u; }
    const size_t kstep = (size_t)(BK * 2);
    const size_t hstep = (size_t)HALF * K * 2;
    const size_t tstep = 2 * hstep;
    const unsigned ldsw = (unsigned)wid * 1024u;
    const int aoff = lds_byte(wr * 64 + fr, fq * 8), boff = lds_byte(wc * 32 + fr, fq * 8);
#define PG8_SA(b, h) (((b) * 2 + (h)) * HTB)
#define PG8_SB(b, h) ((4 + (b) * 2 + (h)) * HTB)
#define PG8_STAGE(bufoff, gbase, voff) do { _Pragma("unroll") for (int _i = 0; _i < 2; ++_i) \
        __builtin_amdgcn_global_load_lds((const unsigned*)((const char*)(gbase) + (voff)[_i]), (PG8_LAS unsigned*)(lds + (bufoff) + ldsw + _i * 8192), 16, 0, 0); } while (0)
#define PG8_LDA(dst, b, h) do { _Pragma("unroll") for (int m = 0; m < 4; ++m) _Pragma("unroll") for (int k = 0; k < 2; ++k) dst[m][k] = *(const PG8_LAS bf16x8*)(lds + PG8_SA(b, h) + aoff + m * 2048 + k * 1024); } while (0)
#define PG8_LDB(dst, b, h) do { _Pragma("unroll") for (int n = 0; n < 2; ++n) _Pragma("unroll") for (int k = 0; k < 2; ++k) dst[n][k] = *(const PG8_LAS bf16x8*)(lds + PG8_SB(b, h) + boff + n * 2048 + k * 1024); } while (0)
#define PG8_MMA(ai, bj, At, Bt) do { __builtin_amdgcn_s_setprio(1); _Pragma("unroll") for (int m = 0; m < 4; ++m) _Pragma("unroll") for (int n = 0; n < 2; ++n) _Pragma("unroll") for (int k = 0; k < 2; ++k) \
        acc[ai][bj][m][n] = __builtin_amdgcn_mfma_f32_16x16x32_bf16(Bt[n][k], At[m][k], acc[ai][bj][m][n], 0, 0, 0); __builtin_amdgcn_s_setprio(0); } while (0)
#define PG8_WAIT_V(n) asm volatile("s_waitcnt vmcnt(" #n ")" ::: "memory")
#define PG8_WAIT_L(n) asm volatile("s_waitcnt lgkmcnt(" #n ")" ::: "memory")
#define PG8_BAR __builtin_amdgcn_s_barrier()
#define PG8_SCHED __builtin_amdgcn_sched_barrier(0)
    Unit cur, nxt; int ui = 0;
    if (!S.next(0, cur)) return;
    f32x4 acc[2][2][4][2];
#pragma unroll
    for (int a = 0; a < 2; ++a)
#pragma unroll
        for (int b = 0; b < 2; ++b)
#pragma unroll
            for (int m = 0; m < 4; ++m)
#pragma unroll
                for (int n = 0; n < 2; ++n) acc[a][b][m][n] = (f32x4){0.f, 0.f, 0.f, 0.f};
    if constexpr (Epi::INIT) E.init(acc, cur, wr, wc, fr, fq);
    bf16x8 At[4][2], B0[2][2], B1[2][2];
    const char* cA = (const char*)g.A + (size_t)cur.pm * tstep; const char* cB = (const char*)g.Bt + (size_t)cur.pn * tstep;
    S.a_ready(cur);
    if constexpr (SP2) {
        PG8_STAGE(PG8_SB(0, 0), cB, voffB); PG8_STAGE(PG8_SB(0, 1), cB + hstep, voffB); PG8_STAGE(PG8_SA(0, 0), cA, voffA); PG8_STAGE(PG8_SA(0, 1), cA + hstep, voffA);
        if (wr == 1) PG8_BAR;
        PG8_WAIT_V(2); PG8_BAR;
        PG8_STAGE(PG8_SB(1, 0), cB + kstep, voffB); PG8_STAGE(PG8_SA(1, 0), cA + kstep, voffA); PG8_STAGE(PG8_SB(1, 1), cB + hstep + kstep, voffB);
        PG8_WAIT_V(6); PG8_BAR;
    } else {
        PG8_STAGE(PG8_SB(0, 0), cB, voffB); PG8_STAGE(PG8_SA(0, 0), cA, voffA); PG8_STAGE(PG8_SB(0, 1), cB + hstep, voffB); PG8_STAGE(PG8_SA(0, 1), cA + hstep, voffA);
        if (wr == 1) PG8_BAR;
        PG8_WAIT_V(4); PG8_BAR;
        PG8_STAGE(PG8_SB(1, 0), cB + kstep, voffB); PG8_STAGE(PG8_SA(1, 0), cA + kstep, voffA); PG8_STAGE(PG8_SB(1, 1), cB + hstep + kstep, voffB);
        PG8_WAIT_V(6); PG8_BAR;
    }
    for (;;) {
        const bool has_next = S.next(ui + 1, nxt);
        const char* nA = has_next ? (const char*)g.A + (size_t)nxt.pm * tstep : cA; const char* nB = has_next ? (const char*)g.Bt + (size_t)nxt.pn * tstep : cB;
        for (int t = 0; t < nt; t += 2) {
            const bool last = (t == nt - 2);
            const char* a1 = cA + (size_t)(t + 1) * kstep;
            const char* a2 = last ? nA : cA + (size_t)(t + 2) * kstep; const char* b2 = last ? nB : cB + (size_t)(t + 2) * kstep;
            const char* a3 = a2 + kstep; const char* b3 = b2 + kstep;
            if (last && has_next) S.a_ready(nxt);
            if constexpr (SP2) {
            PG8_LDB(B0, 0, 0); PG8_LDB(B1, 0, 1); PG8_SCHED; PG8_LDA(At, 0, 0); PG8_STAGE(PG8_SA(1, 1), a1 + hstep, voffA);
            PG8_WAIT_V(8); PG8_WAIT_L(0); PG8_BAR; PG8_MMA(0, 0, At, B0); PG8_MMA(0, 1, At, B1); PG8_BAR; PG8_SCHED;
            PG8_LDA(At, 0, 1); PG8_STAGE(PG8_SB(0, 0), b2, voffB); PG8_STAGE(PG8_SB(0, 1), b2 + hstep, voffB); PG8_STAGE(PG8_SA(0, 0), a2, voffA);
            PG8_WAIT_V(8); PG8_WAIT_L(0); PG8_BAR; PG8_MMA(1, 0, At, B0); PG8_MMA(1, 1, At, B1); PG8_BAR; PG8_SCHED;
            PG8_LDB(B0, 1, 0); PG8_LDB(B1, 1, 1); PG8_SCHED; PG8_LDA(At, 1, 0); PG8_STAGE(PG8_SA(0, 1), a2 + hstep, voffA);
            PG8_WAIT_V(8); PG8_WAIT_L(0); PG8_BAR; PG8_MMA(0, 0, At, B0); PG8_MMA(0, 1, At, B1); PG8_BAR; PG8_SCHED;
            PG8_LDA(At, 1, 1); PG8_STAGE(PG8_SB(1, 0), b3, voffB); PG8_STAGE(PG8_SB(1, 1), b3 + hstep, voffB); PG8_STAGE(PG8_SA(1, 0), a3, voffA);
            PG8_WAIT_V(8); PG8_WAIT_L(0); PG8_BAR; PG8_MMA(1, 0, At, B0); PG8_MMA(1, 1, At, B1); PG8_BAR; PG8_SCHED;
            } else {
            PG8_LDB(B0, 0, 0); PG8_SCHED; PG8_LDA(At, 0, 0); PG8_STAGE(PG8_SA(1, 1), a1 + hstep, voffA);
            PG8_WAIT_L(8); PG8_BAR; PG8_WAIT_L(0); PG8_MMA(0, 0, At, B0); PG8_BAR; PG8_SCHED;
            PG8_LDB(B1, 0, 1); PG8_STAGE(PG8_SB(0, 0), b2, voffB);
            PG8_BAR; PG8_WAIT_L(0); PG8_MMA(0, 1, At, B1); PG8_BAR;
            PG8_LDA(At, 0, 1); PG8_STAGE(PG8_SA(0, 0), a2, voffA);
            PG8_BAR; PG8_WAIT_L(0); PG8_MMA(1, 0, At, B0); PG8_BAR; PG8_SCHED;
            PG8_STAGE(PG8_SB(0, 1), b2 + hstep, voffB);
            PG8_WAIT_V(6); PG8_BAR; PG8_MMA(1, 1, At, B1); PG8_BAR;
            PG8_LDB(B0, 1, 0); PG8_SCHED; PG8_LDA(At, 1, 0); PG8_STAGE(PG8_SA(0, 1), a2 + hstep, voffA);
            PG8_WAIT_L(8); PG8_BAR; PG8_WAIT_L(0); PG8_MMA(0, 0, At, B0); PG8_BAR; PG8_SCHED;
            PG8_LDB(B1, 1, 1); PG8_STAGE(PG8_SB(1, 0), b3, voffB);
            PG8_BAR; PG8_WAIT_L(0); PG8_MMA(0, 1, At, B1); PG8_BAR;
            PG8_LDA(At, 1, 1); PG8_STAGE(PG8_SA(1, 0), a3, voffA);
            PG8_BAR; PG8_WAIT_L(0); PG8_MMA(1, 0, At, B0); PG8_BAR; PG8_SCHED;
            PG8_STAGE(PG8_SB(1, 1), b3 + hstep, voffB);
            PG8_WAIT_V(6); PG8_BAR; PG8_MMA(1, 1, At, B1); PG8_BAR;
            }
        }
        if constexpr (ALIGN_EPI) { if (wr == 0) PG8_BAR; }
        if constexpr (!Epi::AFTER_DRAIN) { E(acc, cur, wr, wc, fr, fq); S.done(cur); }
        if (!has_next) break;
#pragma unroll
        for (int a = 0; a < 2; ++a)
#pragma unroll
            for (int b = 0; b < 2; ++b)
#pragma unroll
                for (int m = 0; m < 4; ++m)
#pragma unroll
                    for (int n = 0; n < 2; ++n) acc[a][b][m][n] = (f32x4){0.f, 0.f, 0.f, 0.f};
        if constexpr (Epi::INIT) E.init(acc, nxt, wr, wc, fr, fq);
        cur = nxt; cA = nA; cB = nB; ++ui;
        if constexpr (ALIGN_EPI) { if (wr == 1) PG8_BAR; }
    }
    PG8_WAIT_V(0);
    if constexpr (!ALIGN_EPI) { if (wr == 0) PG8_BAR; }
    PG8_BAR;
    if constexpr (Epi::AFTER_DRAIN) { E.fused(acc, cur, wr, wc, fr, fq, lds, wid, lane); S.done(cur); }
#undef PG8_SA
#undef PG8_SB
#undef PG8_STAGE
#undef PG8_LDA
#undef PG8_LDB
#undef PG8_MMA
#undef PG8_WAIT_V
#undef PG8_WAIT_L
#undef PG8_BAR
#undef PG8_SCHED
}
}

#define LAS __attribute__((address_space(3)))
using pg8::bf16_t; using pg8::bf16x8; using pg8::f32x4; using pg8::u32x4; using pg8::u32x2;
typedef float f32x16 __attribute__((ext_vector_type(16)));
constexpr int NWAVES = 8, NTHR = 512;
constexpr int LDS_BYTES = 147456;

constexpr size_t MiB = 1u << 20;
constexpr size_t WS_ROPEA = 0, WS_ROPEB = 262144, WS_CTL = 800 * 1024, CTL_BYTES = 65536;
constexpr size_t WS_WIN = 1 * MiB;
constexpr size_t WS_WDV = WS_WIN + (size_t)1792 * 1024 * 2;
constexpr size_t WS_WQ = WS_WDV + (size_t)512 * 1024 * 2;
constexpr size_t WS_WK = WS_WQ + (size_t)768 * 384 * 2;
constexpr size_t WS_WV = WS_WK + (size_t)512 * 256 * 2;
constexpr size_t WS_WO = WS_WV + (size_t)512 * 256 * 2;
constexpr size_t WS_WGU = WS_WO + (size_t)1024 * 1024 * 2;
constexpr size_t WS_WD = WS_WGU + (size_t)5632 * 1024 * 2;
static_assert(WS_WD + (size_t)1024 * 2816 * 2 <= 26 * MiB, "weights");
constexpr size_t WS_SSQQ = 26 * MiB, WS_SSQKV = 26 * MiB + 524288, WS_SSQX = 27 * MiB;
constexpr size_t WS_H = 28 * MiB;
constexpr size_t WS_CQ = 60 * MiB, WS_CKV = 72 * MiB, WS_QA = 80 * MiB, WS_KA = 104 * MiB, WS_VTA = 128 * MiB;
constexpr size_t WS_ABUF = 60 * MiB;
constexpr size_t WS_QD = 148 * MiB, WS_KD = 164 * MiB, WS_VTD = 180 * MiB, WS_O = 196 * MiB, WS_HL = 228 * MiB;
static_assert(WS_ABUF + (size_t)M * FF * 2 <= WS_QD && WS_HL + (size_t)256 * 6 * FF * 4 <= 256 * MiB, "d_ws map");

struct Params {
    const float* in[23]; float* out; unsigned char* ws;
    float invA[16]; float invB[32];
    int ph_lo, ph_hi;
};

__device__ __forceinline__ float wave_sum(float v) {
#pragma unroll
    for (int o = 1; o < 64; o <<= 1) v += shx(v, o);
    return v;
}
__device__ __forceinline__ unsigned pk2(float lo, float hi) { return pg8::cvt_pk_bf16(lo, hi); }

__device__ __forceinline__ void p0_transpose_item(const float* W, int ldw, int K, bf16_t* WT, int drow0, const float* gain, LAS float* scr, int k0, int n0, int lane) {
#pragma unroll 8
    for (int i = 0; i < 32; ++i) { const int kk = 2 * i + (lane >> 5); float v = W[(size_t)(k0 + kk) * ldw + n0 + (lane & 31)]; if (gain) v *= gain[k0 + kk]; scr[kk * 33 + (lane & 31)] = v; }
    asm volatile("s_waitcnt lgkmcnt(0)" ::: "memory");
    const int c = lane & 7;
#pragma unroll
    for (int j = 0; j < 4; ++j) { const int n = (lane >> 3) + 8 * j; const LAS float* s = scr + (8 * c) * 33 + n;
        u32x4 o; o.x = pk2(s[0 * 33], s[1 * 33]); o.y = pk2(s[2 * 33], s[3 * 33]); o.z = pk2(s[4 * 33], s[5 * 33]); o.w = pk2(s[6 * 33], s[7 * 33]);
        *(u32x4*)(WT + (size_t)(drow0 + n) * K + k0 + 8 * c) = o; }
    asm volatile("s_waitcnt lgkmcnt(0)" ::: "memory");
}

__device__ __forceinline__ void convert_items(const Params& p, LAS unsigned char* lds, int it0, int it1, int gw, int NGW, int wave, int lane) {
    unsigned char* ws = p.ws;
    LAS float* scr = (LAS float*)(lds + wave * 16384);
    bf16_t* Win = (bf16_t*)(ws + WS_WIN); bf16_t* Wdv = (bf16_t*)(ws + WS_WDV); bf16_t* Wq = (bf16_t*)(ws + WS_WQ); bf16_t* Wk = (bf16_t*)(ws + WS_WK);
    bf16_t* Wv = (bf16_t*)(ws + WS_WV); bf16_t* Wo = (bf16_t*)(ws + WS_WO); bf16_t* Wgu = (bf16_t*)(ws + WS_WGU); bf16_t* Wd = (bf16_t*)(ws + WS_WD);
    constexpr int I_IN = 16 * 69, I_Q = 6 * 24, I_KV = 4 * 32, I_O = 16 * 32, I_G = 16 * 88, I_D = 44 * 32;
    constexpr int NITEMS = I_IN + I_Q + I_KV + I_O + 2 * I_G + I_D;
    for (int it = it0 + gw; it < it1; it += NGW) {
        int r = it;
        if (r < I_IN) { const int kb = r / 69, nb = r % 69, n0 = nb * 32;
            if (n0 < 1696) { const int L = (n0 < 384) ? n0 : (n0 < 640) ? 512 + (n0 - 384) : (n0 < 672) ? 384 + (n0 - 640) : (n0 < 1184) ? 768 + (n0 - 672) : 1280 + (n0 - 1184);
                const int T = L >> 8, l = L & 255, g = l >> 6, bj = (l >> 5) & 1;
                p0_transpose_item(p.in[2], 2208, 1024, Win, 256 * T + 128 * bj + 32 * g, nullptr, scr, kb * 64, n0, lane); }
            else p0_transpose_item(p.in[2], 2208, 1024, Wdv, n0 - 1696, nullptr, scr, kb * 64, n0, lane);
            continue; }
        r -= I_IN;
        if (r < I_Q) { const int kb = r / 24, nb = r % 24, n0 = nb * 32, h = n0 / 96, blk = (n0 % 96) / 32;
            const int wsl = (blk < 2) ? h : 8 + (h >> 1), bj = (blk < 2) ? blk : (h & 1);
            p0_transpose_item(p.in[4], 768, 384, Wq, 256 * (wsl >> 2) + 128 * bj + 32 * (wsl & 3), p.in[3], scr, kb * 64, n0, lane); continue; }
        r -= I_Q;
        if (r < I_KV) { const int kb = r / 32, nb = r % 32, n0 = nb * 32, h = n0 >> 7, c0 = n0 & 127;
            if (c0 < 64) p0_transpose_item(p.in[6], 1024, 256, Wk, 256 * (h >> 2) + 128 * (c0 >> 5) + 32 * (h & 3), p.in[5], scr, kb * 64, n0, lane);
            else p0_transpose_item(p.in[6], 1024, 256, Wv, h * 64 + (c0 - 64), p.in[5], scr, kb * 64, n0, lane);
            continue; }
        r -= I_KV;
        if (r < I_O) { const int kb = r / 32, nb = r % 32; p0_transpose_item(p.in[16], 1024, 1024, Wo, nb * 32, nullptr, scr, kb * 64, nb * 32, lane); continue; }
        r -= I_O;
        if (r < 2 * I_G) { const int up = r >= I_G; if (up) r -= I_G; const int kb = r / 88, nb = r % 88, f0 = nb * 32;
            p0_transpose_item(p.in[up ? 19 : 18], FF, 1024, Wgu, 256 * (f0 >> 7) + 128 * up + 32 * ((f0 >> 5) & 3), p.in[17], scr, kb * 64, f0, lane); continue; }
        r -= 2 * I_G;
        { const int kb = r / 32, nb = r % 32; p0_transpose_item(p.in[22], 1024, FF, Wd, nb * 32, nullptr, scr, kb * 64, nb * 32, lane); }
    }
}
constexpr int CONV_EARLY = 16 * 69 + 6 * 24 + 4 * 32, CONV_ALL = CONV_EARLY + 16 * 32 + 2 * 16 * 88 + 44 * 32;
__device__ __forceinline__ void p0_prologue(const Params& p, LAS unsigned char* lds, int vcu, int G, int wave, int lane) {
    unsigned char* ws = p.ws;
    const int gw = vcu * NWAVES + wave, NGW = G * NWAVES;
    bf16_t* Win = (bf16_t*)(ws + WS_WIN);
    convert_items(p, lds, 0, CONV_ALL, gw, NGW, wave, lane);
    for (int i = gw * 64 + lane; i < 96 * 128; i += NGW * 64) { const int rr = i >> 7, c = i & 127; const int row = 256 + (rr < 32 ? 352 - 256 + rr : 448 - 256 + (rr - 32)); *(u32x4*)(Win + (size_t)row * 1024 + c * 8) = (u32x4){0u, 0u, 0u, 0u}; }
    float* ropeA = (float*)(ws + WS_ROPEA); float* ropeB = (float*)(ws + WS_ROPEB);
    for (int i = gw * 64 + lane; i < SEQ * 48; i += NGW * 64) {
        const bool isA = i < SEQ * 16; const int e = isA ? i : i - SEQ * 16; const int s = isA ? e >> 4 : e >> 5, k = isA ? e & 15 : e & 31;
        const float ang = (float)s * (isA ? p.invA[k] : p.invB[k]);
        const double rev = (double)ang * 0.15915494309189535; const float fr = (float)(rev - floor(rev));
        const float sn = __builtin_amdgcn_sinf(fr), cs = __builtin_amdgcn_cosf(fr);
        float* dst = (isA ? ropeA : ropeB) + (size_t)e * 2; dst[0] = cs; dst[1] = sn;
    }
    bf16_t* H = (bf16_t*)(ws + WS_H); const float* x = p.in[0]; const float* g = p.in[1];
    f32x4 gv[4];
#pragma unroll
    for (int j = 0; j < 4; ++j) gv[j] = *(const f32x4*)(g + 4 * lane + 256 * j);
    for (int m = gw; m < M; m += NGW) {
        const f32x4* xr = (const f32x4*)(x + (size_t)m * DM) + lane; f32x4 v[4]; float s = 0.f;
#pragma unroll
        for (int j = 0; j < 4; ++j) { v[j] = xr[64 * j]; s += pg8::dot4(v[j]); }
        const float rstd = rsqrtf(wave_sum(s) * (1.f / DM) + EPS);
        unsigned long long* o8 = (unsigned long long*)(H + (size_t)m * DM) + lane;
#pragma unroll
        for (int j = 0; j < 4; ++j) { const f32x4 y = v[j] * gv[j] * rstd; o8[64 * j] = (unsigned long long)pk2(y[0], y[1]) | ((unsigned long long)pk2(y[2], y[3]) << 32); }
    }
}

struct AttnP { const bf16_t *Qa, *Kn, *Kpe, *Vta, *Qd, *Kd, *Vtd; bf16_t* O; const float* subln_g; };
__device__ __forceinline__ bf16x8 packp(const f32x16& p, int b) {
    u32x4 w; w.x = pk2(p[b], p[b + 1]); w.y = pk2(p[b + 2], p[b + 3]); w.z = pk2(p[b + 4], p[b + 5]); w.w = pk2(p[b + 6], p[b + 7]);
    return __builtin_bit_cast(bf16x8, w);
}
template <bool DIFF> __device__ __forceinline__ void attn_unit(LAS unsigned char* lds, const AttnP& P, int b, int h, int qb, float lam, const int wave_s, const int VAR = 0) {
    constexpr int DQK = DIFF ? 64 : 96, DV = DIFF ? 128 : 64, QROWS = DIFF ? 128 : 256, NDB = DV / 32, NS = DQK / 16;
    constexpr int STAGE = DIFF ? 32768 : 20480, V_OFF = DIFF ? 16384 : 12288, NSLOT = 4;
    static_assert(NSLOT * STAGE <= 131072 && 4 * 128 * 32 * 4 <= NSLOT * STAGE + 32768, "attention LDS");
    int tid_ = wave_s * 64 + lane_fresh(); asm volatile("" : "+v"(tid_));
    const int tid = tid_, lane = tid & 63, wid = __builtin_amdgcn_readfirstlane(tid >> 6), r32 = lane & 31, hi = lane >> 5;
    const int map = DIFF ? (wid >> 2) : 0, wq = DIFF ? (wid & 3) : wid;
    const int q0 = qb * QROWS, qw_min = q0 + 32 * wq, qrow = qw_min + r32;
    const size_t mrow0 = (size_t)b * SEQ;
    const bf16_t* Qp = DIFF ? P.Qd + (mrow0 + qrow) * 512 + h * 128 + map * 64 : P.Qa + (mrow0 + qrow) * 768 + h * 96;
    bf16x8 qf[NS];
#pragma unroll
    for (int s = 0; s < NS; ++s) qf[s] = *(const bf16x8*)(Qp + 16 * s + 8 * hi);
    const int NT = (VAR & 16) ? 2 : (q0 + QROWS) / 64;
    const char* src[4]; int dsto[4]; int strd[4]; int nops;
    if (DIFF) {
        nops = 4;
#pragma unroll
        for (int i = 0; i < 2; ++i) { const int j = wid + 8 * i, row = 4 * j + (lane >> 4), c = (lane & 15) ^ (row & 15);
            src[i] = (const char*)(P.Kd + (mrow0 + row) * 512 + h * 128 + c * 8); dsto[i] = j * 1024; strd[i] = 65536; }
#pragma unroll
        for (int i = 0; i < 2; ++i) { const int j = wid + 8 * i, d = 8 * j + (lane >> 3), c = (lane & 7) ^ ((d >> 1) & 7);
            src[2 + i] = (const char*)(P.Vtd + (size_t)(h * 128 + d) * M + mrow0 + c * 8); dsto[2 + i] = V_OFF + j * 1024; strd[2 + i] = 128; }
    } else {
        nops = wid < 4 ? 3 : 2;
        { const int row = 8 * wid + (lane >> 3), c = (lane & 7) ^ ((row >> 1) & 7);
          src[0] = (const char*)(P.Kn + (mrow0 + row) * 512 + h * 64 + c * 8); dsto[0] = wid * 1024; strd[0] = 65536; }
        const int jv1 = wid < 4 ? wid + 4 : wid - 4;
        const int dv_ = 8 * jv1 + (lane >> 3), cv_ = (lane & 7) ^ ((dv_ >> 1) & 7);
        const char* vsrc = (const char*)(P.Vta + (size_t)(h * 64 + dv_) * M + mrow0 + cv_ * 8);
        const int prow = 16 * (wid & 3) + (lane >> 2), pc = (lane & 3) ^ ((prow >> 2) & 3);
        const char* psrc = (const char*)(P.Kpe + (mrow0 + prow) * 32 + pc * 8);
        if (wid < 4) { src[1] = psrc; dsto[1] = 8192 + wid * 1024; strd[1] = 4096; src[2] = vsrc; dsto[2] = V_OFF + jv1 * 1024; strd[2] = 128; }
        else { src[1] = vsrc; dsto[1] = V_OFF + jv1 * 1024; strd[1] = 128; src[2] = vsrc; dsto[2] = 0; strd[2] = 0; }
        src[3] = vsrc; dsto[3] = 0; strd[3] = 0;
    }
#define ATT_DMA(t, slot) do { if (!(VAR & 1)) _Pragma("unroll") for (int i_ = 0; i_ < 4; ++i_) if (i_ < nops) \
        __builtin_amdgcn_global_load_lds((const unsigned*)(src[i_] + (size_t)(t) * strd[i_]), (LAS unsigned*)(lds + (slot) * STAGE + dsto[i_]), 16, 0, 0); } while (0)
    const int x16 = r32 & 15, pi = (r32 & 16) + ((x16 < 4 || x16 >= 12) ? x16 : (x16 < 8 ? x16 + 4 : x16 - 4));
    int kaddr[NS], vaddr[4];
#pragma unroll
    for (int s = 0; s < NS; ++s) {
        if (DIFF) kaddr[s] = pi * 256 + (((8 * map + 2 * s + hi) ^ (pi & 15)) << 4);
        else if (s < 4) kaddr[s] = pi * 128 + (((2 * s + hi) ^ ((pi >> 1) & 7)) << 4);
        else kaddr[s] = 8192 + pi * 64 + (((2 * (s - 4) + hi) ^ ((pi >> 2) & 3)) << 4);
    }
#pragma unroll
    for (int a = 0; a < 4; ++a) vaddr[a] = V_OFF + r32 * 128 + (((2 * a + hi) ^ ((r32 >> 1) & 7)) << 4);
    f32x16 o[NDB];
#pragma unroll
    for (int d = 0; d < NDB; ++d)
#pragma unroll
        for (int r = 0; r < 16; ++r) o[d][r] = 0.f;
    float mref = 0.f, lsum = 0.f;
    f32x16 negm;
#pragma unroll
    for (int r = 0; r < 16; ++r) negm[r] = 0.f;
    __builtin_amdgcn_s_waitcnt(0);
    ATT_DMA(0, 0); ATT_DMA(1, 1);
#define SBAR() __builtin_amdgcn_sched_barrier(0)
#define MX3(a, b, c) __builtin_fmaxf(__builtin_fmaxf((a), (b)), (c))
#define ATT_WAIT(t) do { if (VAR & 1) {} else if ((t) + 1 < NT) { if (DIFF) asm volatile("s_waitcnt vmcnt(4)" ::: "memory"); else if (wid < 4) asm volatile("s_waitcnt vmcnt(3)" ::: "memory"); else asm volatile("s_waitcnt vmcnt(2)" ::: "memory"); } \
        else asm volatile("s_waitcnt vmcnt(0)" ::: "memory"); if (!(VAR & 4)) __builtin_amdgcn_s_barrier(); asm volatile("" ::: "memory"); } while (0)
#define ATT_QK(P0, P1, kb) do { _Pragma("unroll") for (int s = 0; s < NS; ++s) { const int pbo = DIFF ? 8192 : (s < 4 ? 4096 : 2048); \
            const bf16x8 k0 = *(const LAS bf16x8*)((kb) + kaddr[s]), k1 = *(const LAS bf16x8*)((kb) + kaddr[s] + pbo); \
            if (s == 0) { if (DIFF) { f32x16 z; _Pragma("unroll") for (int r = 0; r < 16; ++r) z[r] = 0.f; P0 = __builtin_amdgcn_mfma_f32_32x32x16_bf16(k0, qf[0], z, 0, 0, 0); P1 = __builtin_amdgcn_mfma_f32_32x32x16_bf16(k1, qf[0], z, 0, 0, 0); } \
                          else { P0 = __builtin_amdgcn_mfma_f32_32x32x16_bf16(k0, qf[0], negm, 0, 0, 0); P1 = __builtin_amdgcn_mfma_f32_32x32x16_bf16(k1, qf[0], negm, 0, 0, 0); } } \
            else { P0 = __builtin_amdgcn_mfma_f32_32x32x16_bf16(k0, qf[s], P0, 0, 0, 0); P1 = __builtin_amdgcn_mfma_f32_32x32x16_bf16(k1, qf[s], P1, 0, 0, 0); } } } while (0)
#define ATT_MASK(P0, P1, t) do { if (64 * (t) + 63 > qw_min) { const int kv0 = 64 * (t) + 8 * hi; \
            _Pragma("unroll") for (int r = 0; r < 16; ++r) { const int kv = kv0 + 16 * (r >> 3) + (r & 7); if (kv > qrow) P0[r] = -INFINITY; if (kv + 32 > qrow) P1[r] = -INFINITY; } } } while (0)
#define ATT_ROWMAX(rm, P0, P1) do { float ma = MX3(P0[0], P0[1], P1[0]), mb = MX3(P0[2], P0[3], P1[1]); ma = MX3(ma, P1[2], P1[3]); \
            _Pragma("unroll") for (int r = 4; r < 16; r += 4) { ma = MX3(ma, P0[r], P0[r + 1]); mb = MX3(mb, P0[r + 2], P0[r + 3]); ma = MX3(ma, P1[r], P1[r + 1]); mb = MX3(mb, P1[r + 2], P1[r + 3]); } \
            rm = fmaxf(ma, mb); rm = fmaxf(rm, shx(rm, 32)); } while (0)
#define ATT_SUB(P0, P1, v) do { const pg8::f32x2 m2_ = {(v), (v)}; _Pragma("unroll") for (int r = 0; r < 16; r += 2) { pg8::f32x2 a_ = {P0[r], P0[r + 1]}, b_ = {P1[r], P1[r + 1]}; a_ -= m2_; b_ -= m2_; P0[r] = a_[0]; P0[r + 1] = a_[1]; P1[r] = b_[0]; P1[r + 1] = b_[1]; } } while (0)
#define ATT_EXP(P0, P1) do { if (!(VAR & 2)) _Pragma("unroll") for (int r = 0; r < 16; ++r) { P0[r] = __builtin_amdgcn_exp2f(P0[r]); P1[r] = __builtin_amdgcn_exp2f(P1[r]); } } while (0)
#define ATT_SUMPACK(P0, P1) do { pg8::f32x2 s2 = {0.f, 0.f}; _Pragma("unroll") for (int r = 0; r < 16; r += 2) { s2 += (pg8::f32x2){P0[r], P0[r + 1]}; s2 += (pg8::f32x2){P1[r], P1[r + 1]}; } lsum += s2[0] + s2[1]; \
            pk[0] = packp(P0, 0); pk[1] = packp(P0, 8); pk[2] = packp(P1, 0); pk[3] = packp(P1, 8); } while (0)
#define ATT_PV(kb) do { if (!(VAR & 8)) _Pragma("unroll") for (int d = 0; d < NDB; ++d) _Pragma("unroll") for (int a = 0; a < 4; ++a) { \
            const bf16x8 vf = *(const LAS bf16x8*)((kb) + vaddr[a] + d * 4096); o[d] = __builtin_amdgcn_mfma_f32_32x32x16_bf16(vf, pk[a], o[d], 0, 0, 0); } } while (0)
    f32x16 pa0, pa1, pb0, pb1; bf16x8 pk[4];
    ATT_WAIT(0);
    if (2 < NT) ATT_DMA(2, 2);
    { ATT_QK(pa0, pa1, lds); ATT_MASK(pa0, pa1, 0); float rm; ATT_ROWMAX(rm, pa0, pa1); mref = rm; ATT_SUB(pa0, pa1, rm);
      if (!DIFF) { _Pragma("unroll") for (int r = 0; r < 16; ++r) negm[r] = -mref; }
      ATT_EXP(pa0, pa1); }
    float fpend = 1.f; bool rpend = false;
    for (int t = 1; t < NT; ++t) {
        ATT_WAIT(t);
        if (t + 2 < NT) ATT_DMA(t + 2, (t + 2) & 3);
        const LAS unsigned char* kc = lds + (t & 3) * STAGE; const LAS unsigned char* kp = lds + ((t - 1) & 3) * STAGE;
        if (rpend) {
#pragma unroll
            for (int d = 0; d < NDB; ++d)
#pragma unroll
                for (int r = 0; r < 16; ++r) o[d][r] *= fpend;
        }
        SBAR();
        ATT_QK(pb0, pb1, kc);
        ATT_SUMPACK(pa0, pa1);
#pragma unroll
        for (int i_ = 0; i_ < 2 * NS; ++i_) { __builtin_amdgcn_sched_group_barrier(0x100, 1, 0); __builtin_amdgcn_sched_group_barrier(0x008, 1, 0); __builtin_amdgcn_sched_group_barrier(0x002, DIFF ? 5 : 3, 0); }
        SBAR();
        ATT_MASK(pb0, pb1, t);
        float rm; ATT_ROWMAX(rm, pb0, pb1);
        float f = 1.f; bool resc;
        if (DIFF) { const float rel = rm - mref; resc = __any(rel > 8.0f); if (resc) { const float dl = fmaxf(rel, 0.f); f = __builtin_amdgcn_exp2f(-dl); mref += dl; lsum *= f; } ATT_SUB(pb0, pb1, mref); }
        else { resc = __any(rm > 8.0f); if (resc) { const float dl = fmaxf(rm, 0.f); f = __builtin_amdgcn_exp2f(-dl); mref += dl; lsum *= f; ATT_SUB(pb0, pb1, dl); _Pragma("unroll") for (int r = 0; r < 16; ++r) negm[r] = -mref; } }
        SBAR();
        ATT_PV(kp);
        ATT_EXP(pb0, pb1);
#pragma unroll
        for (int i_ = 0; i_ < 4 * NDB; ++i_) { __builtin_amdgcn_sched_group_barrier(0x100, 1, 0); __builtin_amdgcn_sched_group_barrier(0x008, 1, 0); __builtin_amdgcn_sched_group_barrier(0x002, DIFF ? 2 : 4, 0); }
        SBAR();
        rpend = resc; fpend = f;
        pa0 = pb0; pa1 = pb1;
    }
    if (rpend) {
#pragma unroll
        for (int d = 0; d < NDB; ++d)
#pragma unroll
            for (int r = 0; r < 16; ++r) o[d][r] *= fpend;
    }
    { ATT_SUMPACK(pa0, pa1); ATT_PV(lds + ((NT - 1) & 3) * STAGE); }
#undef ATT_DMA
#undef ATT_WAIT
#undef ATT_QK
#undef ATT_MASK
#undef ATT_ROWMAX
#undef ATT_SUB
#undef ATT_EXP
#undef ATT_SUMPACK
#undef ATT_PV
#undef MX3
#undef SBAR
    asm volatile("s_waitcnt lgkmcnt(0)" ::: "memory"); __builtin_amdgcn_s_barrier(); asm volatile("" ::: "memory");
    const float inv = 1.f / (lsum + shx(lsum, 32));
    if (!DIFF) {
        bf16_t* Op = P.O + (mrow0 + qrow) * 1024 + h * 64;
#pragma unroll
        for (int d = 0; d < NDB; ++d)
#pragma unroll
            for (int g = 0; g < 4; ++g) {
                u32x2 w; w.x = pk2(o[d][4 * g] * inv, o[d][4 * g + 1] * inv); w.y = pk2(o[d][4 * g + 2] * inv, o[d][4 * g + 3] * inv);
                *(u32x2*)(Op + 32 * d + 8 * g + 4 * hi) = w;
            }
    } else {
        LAS float* X = (LAS float*)lds;
        if (map == 1) {
#pragma unroll
            for (int d = 0; d < NDB; ++d)
#pragma unroll
                for (int r = 0; r < 16; ++r) { const int dd = 32 * d + (r & 3) + 8 * (r >> 2) + 4 * hi; X[(wq * 128 + dd) * 32 + r32] = o[d][r] * inv; }
        }
        asm volatile("s_waitcnt lgkmcnt(0)" ::: "memory"); __builtin_amdgcn_s_barrier(); asm volatile("" ::: "memory");
        if (map == 0) {
            float ss = 0.f;
#pragma unroll
            for (int d = 0; d < NDB; ++d)
#pragma unroll
                for (int r = 0; r < 16; ++r) { const int dd = 32 * d + (r & 3) + 8 * (r >> 2) + 4 * hi; const float v = o[d][r] * inv - lam * X[(wq * 128 + dd) * 32 + r32]; o[d][r] = v; ss += v * v; }
            ss += shx(ss, 32);
            const float rs = rsqrtf(ss * (1.f / 128.f) + EPS) * 0.8f;
            bf16_t* Op = P.O + (mrow0 + qrow) * 1024 + 512 + h * 128;
#pragma unroll
            for (int d = 0; d < NDB; ++d)
#pragma unroll
                for (int g = 0; g < 4; ++g) {
                    const int dd = 32 * d + 8 * g + 4 * hi; const f32x4 sg = *(const f32x4*)(P.subln_g + dd);
                    u32x2 w; w.x = pk2(o[d][4 * g] * rs * sg[0], o[d][4 * g + 1] * rs * sg[1]); w.y = pk2(o[d][4 * g + 2] * rs * sg[2], o[d][4 * g + 3] * rs * sg[3]);
                    *(u32x2*)(Op + dd) = w;
                }
        }
        asm volatile("s_waitcnt lgkmcnt(0)" ::: "memory"); __builtin_amdgcn_s_barrier(); asm volatile("" ::: "memory");
    }
}

#ifndef REP0
#define REP0 1
#endif
#ifndef REP1
#define REP1 1
#endif
#ifndef REP2
#define REP2 1
#endif
#ifndef REP3
#define REP3 1
#endif
#ifndef REP4
#define REP4 1
#endif
#ifndef REP5
#define REP5 1
#endif
#ifndef SKIP0
#define SKIP0 0
#endif
#ifndef SKIP1
#define SKIP1 0
#endif
#ifndef SKIP2
#define SKIP2 0
#endif
#ifndef SKIP3
#define SKIP3 0
#endif
#ifndef SKIP4
#define SKIP4 0
#endif
#ifndef SKIP5
#define SKIP5 0
#endif
#ifndef SKIP6
#define SKIP6 0
#endif
#ifndef SKIP7
#define SKIP7 0
#endif
#define XB_TMO      128
#define XB_XCNT(j)  (256  + 64 * (j))
#define XB_XSUB(j)  (1280 + 64 * (j))
#define XB_XGEN(j)  (2304 + 64 * (j))
#define XB_TOP      3328
#define XB_TOPGEN   3392
#define XCD_BAR_WORDS 3456
#define XB_SPIN_CAP (1u << 18)

__device__ __forceinline__ unsigned xb_ld(unsigned* p)              { return __hip_atomic_load(p, __ATOMIC_RELAXED, __HIP_MEMORY_SCOPE_AGENT); }
__device__ __forceinline__ unsigned xb_add(unsigned* p, unsigned v) { return __hip_atomic_fetch_add(p, v, __ATOMIC_RELAXED, __HIP_MEMORY_SCOPE_AGENT); }
__device__ __forceinline__ unsigned xb_xcc_id() { return (unsigned)__builtin_amdgcn_s_getreg((3 << 11) | 20) & 0xFu; }
#define XB_SPIN(cond, bar) do { unsigned _sp = 0; while (cond) { __builtin_amdgcn_s_sleep(1); \
    if ((++_sp & 255u) == 0u) { if (xb_ld(&(bar)[XB_TMO])) break; if (_sp > XB_SPIN_CAP) { atomicAdd(&(bar)[XB_TMO], 1u); break; } } } } while (0)

struct XcdBarrier {
    unsigned* bar; unsigned x;
    volatile LAS unsigned* st;
};

__device__ __forceinline__ XcdBarrier xcd_barrier_post(unsigned* bar, volatile LAS unsigned* st, bool t0) {
    XcdBarrier b; b.bar = bar; b.x = xb_xcc_id(); b.st = st;
    if (t0) (void)xb_add(&bar[XB_XCNT(b.x)], 1u);
    return b;
}
__device__ __forceinline__ void xcd_barrier_complete(unsigned* bar, unsigned x, unsigned& nloc, unsigned& nx) {
    const unsigned G = gridDim.x * gridDim.y * gridDim.z;
    unsigned sum, cnt, mine, sp = 0u;
    for (;;) {
        sum = 0u; cnt = 0u; mine = 0u;
#pragma unroll
        for (unsigned j = 0; j < 16; ++j) { const unsigned c = xb_ld(&bar[XB_XCNT(j)]); sum += c; cnt += (c > 0u) ? 1u : 0u; mine = (j == x) ? c : mine; }
        if (sum == G) break;
        __builtin_amdgcn_s_sleep(1);
        if ((++sp & 255u) == 0u) { if (xb_ld(&bar[XB_TMO])) break; if (sp > XB_SPIN_CAP) { atomicAdd(&bar[XB_TMO], 1u); break; } }
    }
    nloc = mine > 0u ? mine : 1u; nx = cnt > 0u ? cnt : 1u;
}

__device__ __forceinline__ void xcd_barrier(const XcdBarrier& b, bool t0) {
    asm volatile("s_waitcnt vmcnt(0)" ::: "memory");
    __syncthreads();
    if (t0) {
        unsigned* bar = b.bar;
        __builtin_amdgcn_s_waitcnt(0);
        unsigned nloc = b.st[0], nx = b.st[1];
        if (nloc == 0u) { xcd_barrier_complete(bar, b.x, nloc, nx); b.st[0] = nloc; b.st[1] = nx; }
        const unsigned old = xb_add(&bar[XB_XSUB(b.x)], 1u);
        const unsigned gen = old / nloc;
        if (old + 1u == (gen + 1u) * nloc) {
            __builtin_amdgcn_fence(__ATOMIC_RELEASE, "agent");
            asm volatile("s_waitcnt vmcnt(0)" ::: "memory");
            const unsigned og = xb_add(&bar[XB_TOP], 1u);
            const unsigned tg = og / nx;
            if (og + 1u == (tg + 1u) * nx) xb_add(&bar[XB_TOPGEN], 1u);
            else XB_SPIN(xb_ld(&bar[XB_TOPGEN]) == tg, bar);
            __builtin_amdgcn_fence(__ATOMIC_ACQUIRE, "agent");
            xb_add(&bar[XB_XGEN(b.x)], 1u);
            asm volatile("s_waitcnt vmcnt(0)" ::: "memory");
        } else {
            XB_SPIN(xb_ld(&bar[XB_XGEN(b.x)]) == gen, bar);
            __builtin_amdgcn_fence(__ATOMIC_ACQUIRE, "agent");
            asm volatile("s_waitcnt vmcnt(0)" ::: "memory");
        }
    }
    __syncthreads();
}

__global__ void __launch_bounds__(NTHR, 2) fwd_megakernel(Params p) {
    extern __shared__ __attribute__((aligned(16))) unsigned char lds_raw[];
    LAS unsigned char* lds = (LAS unsigned char*)lds_raw;
    cg::grid_group grid = cg::this_grid();
    const int G = gridDim.x, bx = blockIdx.x;
    const int wave_s = __builtin_amdgcn_readfirstlane((int)threadIdx.x >> 6);
#define FRESH_TID() (wave_s * 64 + lane_fresh())
    const int vcu = (G % 8 == 0) ? (bx % 8) * (G / 8) + bx / 8 : bx;
    unsigned char* ws = p.ws;
    const int lo = p.ph_lo, hi = p.ph_hi;
#define IN(k) (lo <= (k) && (k) < hi)
#define SEAM(k) do { if (IN(k) && IN((k) + 1)) { if (p.ph_hi == 0x7fffffff) grid.sync();   xcd_barrier(xbar, FRESH_TID() == 0); } } while (0)
    { const int t_ = FRESH_TID(); if (t_ < 2) ((volatile LAS unsigned*)(lds + 131072 + 8192))[t_] = 0u; }
    __syncthreads();
    XcdBarrier xbar; xbar.bar = (unsigned*)(ws + WS_CTL); xbar.x = 0; xbar.st = nullptr;
    if (hi - lo > 2) xbar = xcd_barrier_post((unsigned*)(ws + WS_CTL), (volatile LAS unsigned*)(lds + 131072 + 8192), FRESH_TID() == 0);
    bf16_t* H = (bf16_t*)(ws + WS_H);
    float* ropeA = (float*)(ws + WS_ROPEA); float* ropeB = (float*)(ws + WS_ROPEB);
    float* ssq_q = (float*)(ws + WS_SSQQ); float* ssq_x1 = (float*)(ws + WS_SSQX);
    bf16_t* CQ = (bf16_t*)(ws + WS_CQ); bf16_t* CKV = (bf16_t*)(ws + WS_CKV); bf16_t* Qa = (bf16_t*)(ws + WS_QA); bf16_t* Ka = (bf16_t*)(ws + WS_KA); bf16_t* Kpe = (bf16_t*)(ws + WS_KA + 16 * MiB); bf16_t* Vta = (bf16_t*)(ws + WS_VTA);
    bf16_t* Qd = (bf16_t*)(ws + WS_QD); bf16_t* Kd = (bf16_t*)(ws + WS_KD); bf16_t* Vtd = (bf16_t*)(ws + WS_VTD); bf16_t* O = (bf16_t*)(ws + WS_O);
    bf16_t* Abuf = (bf16_t*)(ws + WS_ABUF); float* HL = (float*)(ws + WS_HL);

    if (IN(0) && !SKIP0) for (int rep_ = 0; rep_ < REP0; ++rep_) { int t0_ = FRESH_TID(); asm volatile("" : "+v"(t0_)); p0_prologue(p, lds, vcu, G, __builtin_amdgcn_readfirstlane(t0_ >> 6), t0_ & 63); }
    SEAM(0);
    if (IN(1) && !SKIP1) for (int rep_ = 0; rep_ < REP1; ++rep_) {
        { pg8::Gemm g{H, (const bf16_t*)(ws + WS_WIN), M, 1792, 1024}; pg8::StaticOrder S; S.init(M, 1792, G, bx);
          pg8::EpiInProj E{CQ, CKV, Kpe, Qd, Kd, ssq_q, p.in[8], p.in[9], p.in[10], ropeA, ropeB, QSCALE_D, (LAS float*)(lds + 131072), (unsigned*)(ws + WS_CTL + 16384), (unsigned*)(ws + WS_CTL + 16384 + 64 * 256)};
          pg8::gemm_phase<pg8::EpiInProj, pg8::StaticOrder, true, true>(lds, g, S, E, wave_s); }
        { pg8::Gemm g{(const bf16_t*)(ws + WS_WDV), H, 512, M, 1024}; pg8::StaticOrder S; S.init(512, M, G, (bx + G - G / 2) % G);
          pg8::EpiStoreT E{Vtd, M};
          pg8::gemm_phase<pg8::EpiStoreT, pg8::StaticOrder, true, true>(lds, g, S, E, wave_s); }
    }
    if (IN(1) && !SKIP2) {
        unsigned* cntq = (unsigned*)(ws + WS_CTL + 16384); unsigned* cntkv = (unsigned*)(ws + WS_CTL + 16384 + 64 * 256);
#define PANEL_WAIT(cnt, pan, want) do { unsigned sp_ = 0; while (__hip_atomic_load((cnt) + 64 * (pan), __ATOMIC_RELAXED, __HIP_MEMORY_SCOPE_AGENT) < (want)) { __builtin_amdgcn_s_sleep(2); if (++sp_ > (1u << 22)) break; } \
        __builtin_amdgcn_fence(__ATOMIC_ACQUIRE, "agent"); } while (0)
        { pg8::Gemm g{CQ, (const bf16_t*)(ws + WS_WQ), M, 768, 384}; pg8::StaticOrder S; S.init(M, 768, G, (bx + G / 4) % G);
          pg8::Unit u0; if (S.next(0, u0)) PANEL_WAIT(cntq, u0.pm, 16u);
          pg8::EpiQUp E{Qa, ssq_q, p.in[7], ropeA, QSCALE_A};
          pg8::gemm_phase<pg8::EpiQUp, pg8::StaticOrder, true, true>(lds, g, S, E, wave_s); }
        { pg8::Gemm g{CKV, (const bf16_t*)(ws + WS_WK), M, 512, 256}; pg8::StaticOrder S; S.init(M, 512, G, bx);
          pg8::Unit u0; if (S.next(0, u0)) PANEL_WAIT(cntkv, u0.pm, 8u);
          pg8::EpiKUp E{Ka, p.in[8]};
          pg8::gemm_phase<pg8::EpiKUp, pg8::StaticOrder, true, true>(lds, g, S, E, wave_s); }
        { pg8::Gemm g{(const bf16_t*)(ws + WS_WV), CKV, 512, M, 256}; pg8::StaticOrder S; S.init(512, M, G, (bx + G / 4) % G);
          pg8::Unit u0; if (S.next(0, u0)) PANEL_WAIT(cntkv, u0.pn, 8u);
          pg8::EpiStoreT E{Vta, M};
          pg8::gemm_phase<pg8::EpiStoreT, pg8::StaticOrder, true, true>(lds, g, S, E, wave_s); }
#undef PANEL_WAIT
    }
    do { if (IN(1) && IN(3)) { xcd_barrier(xbar, FRESH_TID() == 0); } } while (0);
    if (IN(3) && !SKIP3) for (int rep_ = 0; rep_ < REP3; ++rep_) {
        int t3_ = FRESH_TID(); asm volatile("" : "+v"(t3_)); const int lane = t3_ & 63;
        const float d1 = wave_sum(p.in[11][lane] * p.in[12][lane]), d2 = wave_sum(p.in[13][lane] * p.in[14][lane]);
        const float lam = __expf(d1) - __expf(d2) + 0.2f;
        AttnP P{Qa, Ka, Kpe, Vta, Qd, Kd, Vtd, O, p.in[15]};
#ifdef ATT_VAR
        const int avar = (rep_ == 0) ? ATT_VAR : 0;
#else
        const int avar = 0;
#endif
        for (int su = vcu; su < 256; su += G) {
            { const int bh = su >> 2, s = su & 3; attn_unit<false>(lds, P, bh >> 3, bh & 7, 7 - s, 0.f, wave_s, avar); attn_unit<false>(lds, P, bh >> 3, bh & 7, s, 0.f, wave_s, avar); }
            { const int bh = su >> 3, s = su & 7; attn_unit<true>(lds, P, bh >> 2, bh & 3, 15 - s, lam, wave_s, avar); attn_unit<true>(lds, P, bh >> 2, bh & 3, s, lam, wave_s, avar); }
        }
    }
    SEAM(3);
#ifdef EXTRA_BAR
    xcd_barrier(xbar, FRESH_TID() == 0); xcd_barrier(xbar, FRESH_TID() == 0); xcd_barrier(xbar, FRESH_TID() == 0); xcd_barrier(xbar, FRESH_TID() == 0);
#endif
    if (IN(4) && !SKIP4) for (int rep_ = 0; rep_ < REP4; ++rep_) {
        pg8::Gemm g{O, (const bf16_t*)(ws + WS_WO), M, 1024, 1024}; pg8::StaticOrder S; S.init(M, 1024, G, bx);
        pg8::EpiWOut E{p.in[0], p.out, H, ssq_x1};
        pg8::gemm_phase<pg8::EpiWOut, pg8::StaticOrder, true, true>(lds, g, S, E, wave_s);
    }
    SEAM(4);
    if (IN(5) && !SKIP5) for (int rep_ = 0; rep_ < REP5; ++rep_) {
        pg8::Gemm g{H, (const bf16_t*)(ws + WS_WGU), M, 2 * FF, 1024}; pg8::StaticOrder S; S.init(M, 2 * FF, G, bx);
        pg8::EpiGateUp E{Abuf, HL, ssq_x1, p.in[20], p.in[21]};
        pg8::gemm_phase<pg8::EpiGateUp, pg8::StaticOrder, true, true>(lds, g, S, E, wave_s);
    }
    SEAM(5);
    if (IN(6) && !SKIP6) {
        const float* cw = p.in[20]; const float* cb = p.in[21];
        int tid = FRESH_TID(); asm volatile("" : "+v"(tid));
        for (int i = bx * NTHR + tid; i < 256 * 2 * (FF / 4); i += G * NTHR) {
            const int f = (i % (FF / 4)) * 4, rr = (i / (FF / 4)) & 1, kb = i / (2 * (FF / 4));
            const bool first = (kb & 31) == 0;
            const f32x4 z = (f32x4){0.f, 0.f, 0.f, 0.f};
            const f32x4 gt = *(const f32x4*)(HL + ((size_t)kb * 6 + 2 + rr) * FF + f), ut = *(const f32x4*)(HL + ((size_t)kb * 6 + 4 + rr) * FF + f);
            const f32x4 p63 = first ? z : *(const f32x4*)(HL + ((size_t)(kb - 1) * 6 + 1) * FF + f);
            f32x4 gm1, gm2;
            if (rr == 0) { gm1 = p63; gm2 = first ? z : *(const f32x4*)(HL + ((size_t)(kb - 1) * 6 + 0) * FF + f); }
            else { gm1 = *(const f32x4*)(HL + ((size_t)kb * 6 + 2) * FF + f); gm2 = p63; }
            const f32x4 w0 = *(const f32x4*)(cw + f), w1 = *(const f32x4*)(cw + FF + f), w2 = *(const f32x4*)(cw + 2 * FF + f), b4 = *(const f32x4*)(cb + f);
            f32x4 o;
#pragma unroll
            for (int j = 0; j < 4; ++j) { const float cv = w2[j] * gt[j] + w1[j] * gm1[j] + w0[j] * gm2[j] + b4[j]; o[j] = cv / (1.f + __expf(-cv)) * ut[j]; }
            pg8::store8(Abuf + (size_t)(kb * 64 + rr) * FF + f, pg8::pack4(o));
        }
    }
    SEAM(6);
    if (IN(7) && !SKIP7) {
        pg8::Gemm g{Abuf, (const bf16_t*)(ws + WS_WD), M, 1024, FF}; pg8::StaticOrder S; S.init(M, 1024, G, bx);
#ifdef REP7
        { pg8::EpiDown E0{p.out, (float*)(ws + WS_QD)}; pg8::gemm_phase<pg8::EpiDown, pg8::StaticOrder, true, true>(lds, g, S, E0, wave_s); }
#endif
        pg8::EpiDown E{p.out, p.out};
        pg8::gemm_phase<pg8::EpiDown, pg8::StaticOrder, true, true>(lds, g, S, E, wave_s);
    }
#undef IN
#undef SEAM
}

#ifndef MK_N_LAUNCHES
#define MK_N_LAUNCHES 1
#endif
extern "C" void kernel_launch(void* const* d_in, const int* in_sizes, int n_in, void* d_out, int out_size, void* d_ws, size_t ws_size, hipStream_t stream) {
    static int grid = 0;
    if (grid == 0) {
        int dev = 0, cus = 0, per_cu = 0;
        hipGetDevice(&dev); hipDeviceGetAttribute(&cus, hipDeviceAttributeMultiprocessorCount, dev);
        hipFuncSetAttribute((const void*)fwd_megakernel, hipFuncAttributeMaxDynamicSharedMemorySize, LDS_BYTES);
        hipOccupancyMaxActiveBlocksPerMultiprocessor(&per_cu, (const void*)fwd_megakernel, NTHR, LDS_BYTES);
        (void)hipGetLastError();
        if (per_cu < 1) per_cu = 1;
        grid = cus * 1;
        if (grid <= 0) grid = 256;
    }
    Params p{};
    for (int i = 0; i < 23; ++i) p.in[i] = (const float*)d_in[i];
    p.out = (float*)d_out; p.ws = (unsigned char*)d_ws;
    for (int i = 0; i < 16; ++i) p.invA[i] = 1.0f / powf(10000.0f, (float)(2 * i) / 32.0f);
    for (int i = 0; i < 32; ++i) p.invB[i] = 1.0f / powf(10000.0f, (float)(2 * i) / 64.0f);
#if MK_N_LAUNCHES == 1
    p.ph_lo = 0; p.ph_hi = 8;
    hipMemsetAsync((char*)d_ws + WS_CTL, 0, CTL_BYTES, stream);
    void* args[] = {&p};
    hipError_t e = hipLaunchCooperativeKernel((const void*)fwd_megakernel, dim3(grid), dim3(NTHR), args, LDS_BYTES, stream);
    if (e != hipSuccess) fprintf(stderr, "cooperative launch failed: %s (grid %d)\n", hipGetErrorString(e), grid);
#else
    for (int ph = 0; ph < 8; ++ph) { p.ph_lo = ph; p.ph_hi = ph + 1; hipLaunchKernelGGL(fwd_megakernel, dim3(grid), dim3(NTHR), LDS_BYTES, stream, p); }
#endif
}
```

```cpp
#include <hip/hip_runtime.h>
#include <hip/hip_cooperative_groups.h>
#include <cstdio>
#include <cstdint>
#include <cmath>
namespace cg = cooperative_groups;

constexpr int BATCH = 8, SEQ = 2048, DM = 1024, M = BATCH * SEQ;
constexpr int FF = 2816;
constexpr float EPS = 1e-6f;
constexpr float LOG2E = 1.4426950408889634f;
constexpr float QSCALE_A = 0.10206207261596577f * LOG2E;
constexpr float QSCALE_D = 0.125f * LOG2E;

__device__ __forceinline__ int lane_fresh() { int l; asm volatile("v_mbcnt_lo_u32_b32 %0, -1, 0\n\tv_mbcnt_hi_u32_b32 %0, -1, %0" : "=v"(l)); return l; }
__device__ __forceinline__ float shx(float v, int mask) { const int idx = (lane_fresh() ^ mask) << 2; return __builtin_bit_cast(float, __builtin_amdgcn_ds_bpermute(idx, __builtin_bit_cast(int, v))); }
__device__ __forceinline__ float shl(float v, int src) { return __builtin_bit_cast(float, __builtin_amdgcn_ds_bpermute(src << 2, __builtin_bit_cast(int, v))); }
namespace pg8 {
#define PG8_LAS __attribute__((address_space(3)))
typedef unsigned short bf16_t;
typedef short bf16x8 __attribute__((ext_vector_type(8)));
typedef float f32x4 __attribute__((ext_vector_type(4)));
typedef unsigned u32x4 __attribute__((ext_vector_type(4)));
constexpr int BM = 256, BK = 64, HALF = 128, HTB = HALF * BK * 2  , STAGE_BYTES = 8 * HTB, NXCD = 8, WGM = 8;

__host__ __device__ __forceinline__ int lds_byte(int r, int c) { const int st = (r >> 4) * 2 + (c >> 5), rr = r & 15, cc = c & 31, ob = rr * 64 + cc * 2; return st * 1024 + (ob ^ (((ob >> 9) & 1) << 5)); }
__host__ __device__ __forceinline__ void stage_rc(int b, int& R, int& C) { const int st = b / 1024, sb = b % 1024, swz = sb ^ (((sb >> 9) & 1) << 5); R = (st >> 1) * 16 + swz / 64; C = (st & 1) * 32 + (swz % 64) / 2; }
__host__ __device__ __forceinline__ int perm32(int rho) { const int n = rho >> 4, i = rho & 15; return 8 * (i >> 2) + 4 * n + (i & 3); }

struct Unit { int pm, pn; };
struct Gemm { const bf16_t* A; const bf16_t* Bt; int M, N, K; };

struct StaticOrder {
    int nM, nN, nwg, G, c;
    __host__ __device__ void init(int M, int N, int G_, int c_) { nM = M / BM; nN = N / BM; nwg = nM * nN; G = G_; c = c_; }
    __host__ __device__ bool next(int i, Unit& u) const {
        const long L = (long)i * G + c; if (L >= nwg) return false;
        int wgid = (int)L; { const int q = nwg / NXCD, r = nwg % NXCD, xcd = wgid % NXCD, off = wgid / NXCD; wgid = (xcd < r ? xcd * (q + 1) : r * (q + 1) + (xcd - r) * q) + off; }
        const int nig = WGM * nN, gid = wgid / nig, fm = gid * WGM, gsz = (nM - fm) < WGM ? (nM - fm) : WGM;
        u.pm = fm + ((wgid % nig) % gsz); u.pn = (wgid % nig) / gsz; return true;
    }
    __device__ __forceinline__ void a_ready(const Unit&) const {}
    __device__ __forceinline__ void done(const Unit&) const {}
};

typedef unsigned u32x2 __attribute__((ext_vector_type(2)));
typedef float f32x2 __attribute__((ext_vector_type(2)));
typedef __bf16 bf16x2_t __attribute__((ext_vector_type(2)));
__device__ __forceinline__ unsigned cvt_pk_bf16(float lo, float hi) { f32x2 v = {lo, hi}; bf16x2_t b = __builtin_convertvector(v, bf16x2_t); return __builtin_bit_cast(unsigned, b); }
__device__ __forceinline__ u32x2 pack4(f32x4 v) { u32x2 w; w.x = cvt_pk_bf16(v[0], v[1]); w.y = cvt_pk_bf16(v[2], v[3]); return w; }
__device__ __forceinline__ void store8(bf16_t* p, u32x2 w) { *(u32x2*)p = w; }
__device__ __forceinline__ void store8_wt(bf16_t* p, u32x2 w) { __hip_atomic_store((unsigned long long*)p, (unsigned long long)w.x | ((unsigned long long)w.y << 32), __ATOMIC_RELAXED, __HIP_MEMORY_SCOPE_AGENT); }
__device__ __forceinline__ float dot4(f32x4 v) { return (v[0] * v[0] + v[1] * v[1]) + (v[2] * v[2] + v[3] * v[3]); }
__device__ __forceinline__ float red_fq(float s) { s += shx(s, 16); s += shx(s, 32); return s; }
constexpr float EPSN = 1e-6f;

struct EpiInProj {
    static constexpr bool PERM = false, AFTER_DRAIN = false, INIT = false;
    bf16_t *CQ, *CKV, *Kpe, *Qd, *Kd; float *ssq_q; const float *gk, *gdq, *gdk; const float* ropeA; const float* ropeB; float qscale_d; PG8_LAS float* part; unsigned* cntq; unsigned* cntkv;
    __device__ __forceinline__ void operator()(const f32x4 (&acc)[2][2][4][2], const Unit& u, int wr, int wc, int fr, int fq) const {
        asm volatile("" : "+v"(fr), "+v"(fq));
        const int pn = u.pn;
        if (pn == 2) {
#pragma unroll
            for (int ai = 0; ai < 2; ++ai)
#pragma unroll
                for (int m = 0; m < 4; ++m) {
                    float ss = 0.f;
#pragma unroll
                    for (int bj = 0; bj < 2; ++bj)
#pragma unroll
                        for (int n = 0; n < 2; ++n) ss += dot4(acc[ai][bj][m][n]);
                    ss = red_fq(ss);
                    if (fq == 0) part[(ai * HALF + wr * 64 + m * 16 + fr) * 4 + wc] = ss;
                }
            asm volatile("s_waitcnt lgkmcnt(0)" ::: "memory"); __builtin_amdgcn_s_barrier(); asm volatile("" ::: "memory");
#pragma unroll
            for (int ai = 0; ai < 2; ++ai)
#pragma unroll
                for (int m = 0; m < 4; ++m) {
                    const int rl = ai * HALF + wr * 64 + m * 16 + fr, row = u.pm * BM + rl;
                    const f32x4 q = *(const PG8_LAS f32x4*)(part + rl * 4);
                    const float rstd = rsqrtf(((q[0] + q[1]) + (q[2] + q[3])) * (1.f / 256.f) + EPSN);
                    bf16_t* dst = CKV + (size_t)row * 256 + 64 * wc;
#pragma unroll
                    for (int bj = 0; bj < 2; ++bj)
#pragma unroll
                        for (int n = 0; n < 2; ++n) store8_wt(dst + 32 * bj + 16 * n + 4 * fq, pack4(acc[ai][bj][m][n] * rstd));
                }
            asm volatile("s_waitcnt vmcnt(0)" ::: "memory");
            if (fr == 0 && fq == 0) __hip_atomic_fetch_add(cntkv + 64 * u.pm, 1u, __ATOMIC_RELAXED, __HIP_MEMORY_SCOPE_AGENT);
            return;
        }
#pragma unroll
        for (int ai = 0; ai < 2; ++ai)
#pragma unroll
            for (int m = 0; m < 4; ++m) {
                const int row = u.pm * BM + ai * HALF + wr * 64 + m * 16 + fr;
                if (pn < 2) {
                    if (pn != 1 || wc < 2) {
                        bf16_t* dst = CQ + (size_t)row * 384 + pn * 256 + 64 * wc;
                        float ss = 0.f;
#pragma unroll
                        for (int bj = 0; bj < 2; ++bj)
#pragma unroll
                            for (int n = 0; n < 2; ++n) { const f32x4 v = acc[ai][bj][m][n]; ss += dot4(v); store8_wt(dst + 32 * bj + 16 * n + 4 * fq, pack4(v)); }
                        ss = red_fq(ss);
                        if (fq == 0) __hip_atomic_store(ssq_q + (size_t)row * 8 + pn * 4 + wc, ss, __ATOMIC_RELAXED, __HIP_MEMORY_SCOPE_AGENT);
                    } else if (wc == 2) {
                        const f32x4 v0 = acc[ai][0][m][0], v1 = acc[ai][0][m][1];
                        float ss = red_fq(dot4(v0) + dot4(v1));
                        const float rstd = rsqrtf(ss * (1.f / 32.f) + EPSN);
                        const int s = row & (SEQ - 1);
                        const f32x4 g0 = *(const f32x4*)(gk + 64 + 4 * fq), g1 = *(const f32x4*)(gk + 80 + 4 * fq);
                        const f32x4 r0 = *(const f32x4*)(ropeA + (size_t)(s * 16 + 4 * fq) * 2), r1 = *(const f32x4*)(ropeA + (size_t)(s * 16 + 4 * fq) * 2 + 4);
                        const float cs[4] = {r0[0], r0[2], r1[0], r1[2]}, sn[4] = {r0[1], r0[3], r1[1], r1[3]};
                        f32x4 o1, o2;
#pragma unroll
                        for (int j = 0; j < 4; ++j) { const float x1 = v0[j] * rstd * g0[j], x2 = v1[j] * rstd * g1[j]; o1[j] = x1 * cs[j] - x2 * sn[j]; o2[j] = x2 * cs[j] + x1 * sn[j]; }
                        const u32x2 w1 = pack4(o1), w2 = pack4(o2);
                        store8(Kpe + (size_t)row * 32 + 4 * fq, w1); store8(Kpe + (size_t)row * 32 + 16 + 4 * fq, w2);
                    }
                } else {
                    const bool isq = pn < 5;
                    const int G8 = ((pn - 3) & 1) * 4 + wc;
                    const float* g = isq ? gdq : gdk;
                    bf16_t* dst = (isq ? Qd : Kd) + (size_t)row * 512 + G8 * 64;
                    float ss = 0.f;
#pragma unroll
                    for (int bj = 0; bj < 2; ++bj)
#pragma unroll
                        for (int n = 0; n < 2; ++n) ss += dot4(acc[ai][bj][m][n]);
                    ss = red_fq(ss);
                    const float rstd = rsqrtf(ss * (1.f / 64.f) + EPSN) * (isq ? qscale_d : 1.f);
                    const int s = row & (SEQ - 1);
#pragma unroll
                    for (int n = 0; n < 2; ++n) {
                        const int i0 = 16 * n + 4 * fq;
                        const f32x4 g0 = *(const f32x4*)(g + i0), g1 = *(const f32x4*)(g + 32 + i0);
                        const f32x4 r0 = *(const f32x4*)(ropeB + (size_t)(s * 32 + i0) * 2), r1 = *(const f32x4*)(ropeB + (size_t)(s * 32 + i0) * 2 + 4);
                        const float cs[4] = {r0[0], r0[2], r1[0], r1[2]}, sn[4] = {r0[1], r0[3], r1[1], r1[3]};
                        const f32x4 v0 = acc[ai][0][m][n], v1 = acc[ai][1][m][n];
                        f32x4 o1, o2;
#pragma unroll
                        for (int j = 0; j < 4; ++j) { const float x1 = v0[j] * rstd * g0[j], x2 = v1[j] * rstd * g1[j]; o1[j] = x1 * cs[j] - x2 * sn[j]; o2[j] = x2 * cs[j] + x1 * sn[j]; }
                        store8(dst + i0, pack4(o1)); store8(dst + 32 + i0, pack4(o2));
                    }
                }
            }
        if (pn < 2) {
            asm volatile("s_waitcnt vmcnt(0)" ::: "memory");
            if (fr == 0 && fq == 0) __hip_atomic_fetch_add(cntq + 64 * u.pm, 1u, __ATOMIC_RELAXED, __HIP_MEMORY_SCOPE_AGENT);
        }
    }
};

struct EpiStoreT {
    static constexpr bool PERM = false, AFTER_DRAIN = false, INIT = false;
    bf16_t* O; int ldo;
    __device__ __forceinline__ void operator()(const f32x4 (&acc)[2][2][4][2], const Unit& u, int wr, int wc, int fr, int fq) const {
        asm volatile("" : "+v"(fr), "+v"(fq));
        const int tok0 = u.pn * BM + wc * 32 + 4 * fq;
#pragma unroll
        for (int ai = 0; ai < 2; ++ai)
#pragma unroll
            for (int m = 0; m < 4; ++m) {
                const int row = u.pm * BM + ai * HALF + wr * 64 + m * 16 + fr;
                bf16_t* rp = O + (size_t)row * ldo + tok0;
#pragma unroll
                for (int bj = 0; bj < 2; ++bj)
#pragma unroll
                    for (int n = 0; n < 2; ++n) store8(rp + bj * HALF + n * 16, pack4(acc[ai][bj][m][n]));
            }
    }
};

struct EpiQUp {
    static constexpr bool PERM = false, AFTER_DRAIN = false, INIT = false;
    bf16_t* Qa; const float* ssq_q; const float* gq; const float* ropeA; float qscale;
    __device__ __forceinline__ void operator()(const f32x4 (&acc)[2][2][4][2], const Unit& u, int wr, int wc, int fr, int fq) const {
        asm volatile("" : "+v"(fr), "+v"(fq));
        const int ws = 4 * u.pn + wc;
#pragma unroll
        for (int ai = 0; ai < 2; ++ai)
#pragma unroll
            for (int m = 0; m < 4; ++m) {
                const int row = u.pm * BM + ai * HALF + wr * 64 + m * 16 + fr;
                float sq = 0.f; if (fq < 3) { const f32x2 qa = *(const f32x2*)(ssq_q + (size_t)row * 8 + 2 * fq); sq = qa[0] + qa[1]; }
                const float rstd_a = rsqrtf(red_fq(sq) * (1.f / 384.f) + EPSN);
                if (ws < 8) {
                    float ss = 0.f;
#pragma unroll
                    for (int bj = 0; bj < 2; ++bj)
#pragma unroll
                        for (int n = 0; n < 2; ++n) ss += dot4(acc[ai][bj][m][n] * rstd_a);
                    ss = red_fq(ss);
                    const float r2 = rsqrtf(ss * (1.f / 64.f) + EPSN) * qscale * rstd_a;
                    bf16_t* dst = Qa + (size_t)row * 768 + ws * 96;
#pragma unroll
                    for (int bj = 0; bj < 2; ++bj)
#pragma unroll
                        for (int n = 0; n < 2; ++n) { const int d0 = 32 * bj + 16 * n + 4 * fq; const f32x4 g = *(const f32x4*)(gq + d0); store8(dst + d0, pack4(acc[ai][bj][m][n] * g * r2)); }
                } else {
                    const int s = row & (SEQ - 1);
                    const f32x4 g0 = *(const f32x4*)(gq + 64 + 4 * fq), g1 = *(const f32x4*)(gq + 80 + 4 * fq);
                    const f32x4 r0 = *(const f32x4*)(ropeA + (size_t)(s * 16 + 4 * fq) * 2), r1 = *(const f32x4*)(ropeA + (size_t)(s * 16 + 4 * fq) * 2 + 4);
                    const float cs[4] = {r0[0], r0[2], r1[0], r1[2]}, sn[4] = {r0[1], r0[3], r1[1], r1[3]};
#pragma unroll
                    for (int bj = 0; bj < 2; ++bj) {
                        const int h = 2 * (ws - 8) + bj;
                        const f32x4 v0 = acc[ai][bj][m][0] * rstd_a, v1 = acc[ai][bj][m][1] * rstd_a;
                        const float ss = red_fq(dot4(v0) + dot4(v1));
                        const float r2 = rsqrtf(ss * (1.f / 32.f) + EPSN);
                        f32x4 o1, o2;
#pragma unroll
                        for (int j = 0; j < 4; ++j) { const float x1 = v0[j] * r2 * g0[j], x2 = v1[j] * r2 * g1[j]; o1[j] = (x1 * cs[j] - x2 * sn[j]) * qscale; o2[j] = (x2 * cs[j] + x1 * sn[j]) * qscale; }
                        bf16_t* dst = Qa + (size_t)row * 768 + h * 96 + 64 + 4 * fq;
                        store8(dst, pack4(o1)); store8(dst + 16, pack4(o2));
                    }
                }
                asm volatile("" ::: "memory");
            }
    }
};

struct EpiKUp {
    static constexpr bool PERM = false, AFTER_DRAIN = false, INIT = false;
    bf16_t* Ka; const float* gk;
    __device__ __forceinline__ void operator()(const f32x4 (&acc)[2][2][4][2], const Unit& u, int wr, int wc, int fr, int fq) const {
        asm volatile("" : "+v"(fr), "+v"(fq));
        const int h = 4 * u.pn + wc;
#pragma unroll
        for (int ai = 0; ai < 2; ++ai)
#pragma unroll
            for (int m = 0; m < 4; ++m) {
                const int row = u.pm * BM + ai * HALF + wr * 64 + m * 16 + fr;
                float ss = 0.f;
#pragma unroll
                for (int bj = 0; bj < 2; ++bj)
#pragma unroll
                    for (int n = 0; n < 2; ++n) ss += dot4(acc[ai][bj][m][n]);
                ss = red_fq(ss);
                const float r2 = rsqrtf(ss * (1.f / 64.f) + EPSN);
                bf16_t* dst = Ka + (size_t)row * 512 + h * 64;
#pragma unroll
                for (int bj = 0; bj < 2; ++bj)
#pragma unroll
                    for (int n = 0; n < 2; ++n) { const int d0 = 32 * bj + 16 * n + 4 * fq; const f32x4 g = *(const f32x4*)(gk + d0); store8(dst + d0, pack4(acc[ai][bj][m][n] * g * r2)); }
            }
    }
};

struct EpiWOut {
    static constexpr bool PERM = false, AFTER_DRAIN = false, INIT = true;
    const float* x; float* out; bf16_t* X1b; float* ssq_x1;
    __device__ __forceinline__ void init(f32x4 (&acc)[2][2][4][2], const Unit& u, int wr, int wc, int fr, int fq) const {
        const int col0 = u.pn * BM + wc * 32 + 4 * fq;
#pragma unroll
        for (int ai = 0; ai < 2; ++ai)
#pragma unroll
            for (int m = 0; m < 4; ++m) {
                const size_t off = (size_t)(u.pm * BM + ai * HALF + wr * 64 + m * 16 + fr) * DM + col0;
#pragma unroll
                for (int bj = 0; bj < 2; ++bj)
#pragma unroll
                    for (int n = 0; n < 2; ++n) acc[ai][bj][m][n] = *(const f32x4*)(x + off + bj * HALF + n * 16);
            }
    }
    __device__ __forceinline__ void operator()(const f32x4 (&acc)[2][2][4][2], const Unit& u, int wr, int wc, int fr, int fq) const {
        asm volatile("" : "+v"(fr), "+v"(fq));
        const int col0 = u.pn * BM + wc * 32 + 4 * fq;
#pragma unroll
        for (int ai = 0; ai < 2; ++ai)
#pragma unroll
            for (int m = 0; m < 4; ++m) {
                const int row = u.pm * BM + ai * HALF + wr * 64 + m * 16 + fr;
                const size_t off = (size_t)row * DM + col0;
                float ss = 0.f;
#pragma unroll
                for (int bj = 0; bj < 2; ++bj)
#pragma unroll
                    for (int n = 0; n < 2; ++n) {
                        const size_t o = off + bj * HALF + n * 16;
                        const f32x4 v = acc[ai][bj][m][n];
                        *(f32x4*)(out + o) = v; store8(X1b + o, pack4(v)); ss += dot4(v);
                    }
                ss = red_fq(ss);
                if (fq == 0) ssq_x1[(size_t)row * 16 + u.pn * 4 + wc] = ss;
            }
    }
};

struct EpiGateUp {
    static constexpr bool PERM = false, AFTER_DRAIN = false, INIT = false;
    bf16_t* A; float* HL; const float* ssq_x1; const float* conv_w; const float* conv_b;
    __device__ __forceinline__ void operator()(f32x4 (&acc)[2][2][4][2], const Unit& u, int wr, int wc, int fr, int fq) const {
        asm volatile("" : "+v"(fr), "+v"(fq));
        const int lane = fq * 16 + fr;
        const int src1 = (lane & ~15) | ((fr + 15) & 15), src2 = (lane & ~15) | ((fr + 14) & 15);
#pragma unroll
        for (int ai = 0; ai < 2; ++ai)
#pragma unroll
            for (int m = 0; m < 4; ++m) {
                const int row = u.pm * BM + ai * HALF + wr * 64 + m * 16 + fr;
                const f32x4 a = *(const f32x4*)(ssq_x1 + (size_t)row * 16 + 4 * fq);
                const float rs = rsqrtf(red_fq((a[0] + a[1]) + (a[2] + a[3])) * (1.f / 1024.f) + EPSN);
#pragma unroll
                for (int bj = 0; bj < 2; ++bj)
#pragma unroll
                    for (int n = 0; n < 2; ++n) acc[ai][bj][m][n] *= rs;
            }
#pragma unroll
        for (int n = 0; n < 2; ++n) {
            const int f = u.pn * 128 + wc * 32 + 16 * n + 4 * fq;
            const f32x4 w0 = *(const f32x4*)(conv_w + f), w1 = *(const f32x4*)(conv_w + FF + f), w2 = *(const f32x4*)(conv_w + 2 * FF + f), cb = *(const f32x4*)(conv_b + f);
#pragma unroll
            for (int ai = 0; ai < 2; ++ai) {
                f32x4 gprev = (f32x4){0.f, 0.f, 0.f, 0.f};
                const int kb = u.pm * 4 + ai * 2 + wr;
#pragma unroll
                for (int m = 0; m < 4; ++m) {
                    const int row = u.pm * BM + ai * HALF + wr * 64 + m * 16 + fr;
                    const f32x4 gc = acc[ai][0][m][n], uc = acc[ai][1][m][n];
                    f32x4 o;
#pragma unroll
                    for (int j = 0; j < 4; ++j) {
                        const float y1 = (fr == 15) ? gprev[j] : gc[j], y2 = (fr >= 14) ? gprev[j] : gc[j];
                        const float g1 = shl(y1, src1), g2 = shl(y2, src2);
                        const float cv = w2[j] * gc[j] + w1[j] * g1 + w0[j] * g2 + cb[j];
                        o[j] = cv / (1.f + __expf(-cv)) * uc[j];
                    }
                    if (m != 0 || fr >= 2) store8(A + (size_t)row * FF + f, pack4(o));
                    if (m == 0 && fr < 2) { *(f32x4*)(HL + ((size_t)kb * 6 + 2 + fr) * FF + f) = gc; *(f32x4*)(HL + ((size_t)kb * 6 + 4 + fr) * FF + f) = uc; }
                    if (m == 3 && fr >= 14) *(f32x4*)(HL + ((size_t)kb * 6 + (fr - 14)) * FF + f) = gc;
                    gprev = gc;
                }
            }
        }
    }
};

struct EpiDown {
    static constexpr bool PERM = false, AFTER_DRAIN = false, INIT = true;
    const float* src; float* out;
    __device__ __forceinline__ void init(f32x4 (&acc)[2][2][4][2], const Unit& u, int wr, int wc, int fr, int fq) const {
        const int col0 = u.pn * BM + wc * 32 + 4 * fq;
#pragma unroll
        for (int ai = 0; ai < 2; ++ai)
#pragma unroll
            for (int m = 0; m < 4; ++m) {
                const size_t off = (size_t)(u.pm * BM + ai * HALF + wr * 64 + m * 16 + fr) * DM + col0;
#pragma unroll
                for (int bj = 0; bj < 2; ++bj)
#pragma unroll
                    for (int n = 0; n < 2; ++n) acc[ai][bj][m][n] = *(const f32x4*)(src + off + bj * HALF + n * 16);
            }
    }
    __device__ __forceinline__ void operator()(const f32x4 (&acc)[2][2][4][2], const Unit& u, int wr, int wc, int fr, int fq) const {
        asm volatile("" : "+v"(fr), "+v"(fq));
        const int col0 = u.pn * BM + wc * 32 + 4 * fq;
#pragma unroll
        for (int ai = 0; ai < 2; ++ai)
#pragma unroll
            for (int m = 0; m < 4; ++m) {
                const size_t off = (size_t)(u.pm * BM + ai * HALF + wr * 64 + m * 16 + fr) * DM + col0;
#pragma unroll
                for (int bj = 0; bj < 2; ++bj)
#pragma unroll
                    for (int n = 0; n < 2; ++n) *(f32x4*)(out + off + bj * HALF + n * 16) = acc[ai][bj][m][n];
            }
    }
};

template <class Epi, class Sched, bool ALIGN_EPI = false, bool SP2 = false>
__device__ __forceinline__ void gemm_phase(PG8_LAS unsigned char* lds, const Gemm g, const Sched& S, const Epi& E, const int wave_s) {
    int tid_ = wave_s * 64 + lane_fresh(); asm volatile("" : "+v"(tid_));
    const int tid = tid_, wid = __builtin_amdgcn_readfirstlane(tid >> 6), lane = tid & 63, wr = wid >> 2, wc = wid & 3, fr = lane & 15, fq = lane >> 4;
    const int K = g.K, nt = K / BK;
    unsigned voffA[2], voffB[2];
#pragma unroll
    for (int i = 0; i < 2; ++i) { int R, C; stage_rc(tid * 16 + i * 8192, R, C); const int Rb = Epi::PERM ? ((R & ~31) + perm32(R & 31)) : R;
        voffA[i] = (unsigned)(R * K + C) * 2u; voffB[i] = (unsigned)(Rb * K + C) * 2u; }
    const size_t kstep = (size_t)(BK * 2);
    const size_t hstep = (size_t)HALF * K * 2;
    const size_t tstep = 2 * hstep;
    const unsigned ldsw = (unsigned)wid * 1024u;
    const int aoff = lds_byte(wr * 64 + fr, fq * 8), boff = lds_byte(wc * 32 + fr, fq * 8);
#define PG8_SA(b, h) (((b) * 2 + (h)) * HTB)
#define PG8_SB(b, h) ((4 + (b) * 2 + (h)) * HTB)
#define PG8_STAGE(bufoff, gbase, voff) do { _Pragma("unroll") for (int _i = 0; _i < 2; ++_i) \
        __builtin_amdgcn_global_load_lds((const unsigned*)((const char*)(gbase) + (voff)[_i]), (PG8_LAS unsigned*)(lds + (bufoff) + ldsw + _i * 8192), 16, 0, 0); } while (0)
#define PG8_LDA(dst, b, h) do { _Pragma("unroll") for (int m = 0; m < 4; ++m) _Pragma("unroll") for (int k = 0; k < 2; ++k) dst[m][k] = *(const PG8_LAS bf16x8*)(lds + PG8_SA(b, h) + aoff + m * 2048 + k * 1024); } while (0)
#define PG8_LDB(dst, b, h) do { _Pragma("unroll") for (int n = 0; n < 2; ++n) _Pragma("unroll") for (int k = 0; k < 2; ++k) dst[n][k] = *(const PG8_LAS bf16x8*)(lds + PG8_SB(b, h) + boff + n * 2048 + k * 1024); } while (0)
#define PG8_MMA(ai, bj, At, Bt) do { __builtin_amdgcn_s_setprio(1); _Pragma("unroll") for (int m = 0; m < 4; ++m) _Pragma("unroll") for (int n = 0; n < 2; ++n) _Pragma("unroll") for (int k = 0; k < 2; ++k) \
        acc[ai][bj][m][n] = __builtin_amdgcn_mfma_f32_16x16x32_bf16(Bt[n][k], At[m][k], acc[ai][bj][m][n], 0, 0, 0); __builtin_amdgcn_s_setprio(0); } while (0)
#define PG8_WAIT_V(n) asm volatile("s_waitcnt vmcnt(" #n ")" ::: "memory")
#define PG8_WAIT_L(n) asm volatile("s_waitcnt lgkmcnt(" #n ")" ::: "memory")
#define PG8_BAR __builtin_amdgcn_s_barrier()
#define PG8_SCHED __builtin_amdgcn_sched_barrier(0)
    Unit cur, nxt; int ui = 0;
    if (!S.next(0, cur)) return;
    f32x4 acc[2][2][4][2];
#pragma unroll
    for (int a = 0; a < 2; ++a)
#pragma unroll
        for (int b = 0; b < 2; ++b)
#pragma unroll
            for (int m = 0; m < 4; ++m)
#pragma unroll
                for (int n = 0; n < 2; ++n) acc[a][b][m][n] = (f32x4){0.f, 0.f, 0.f, 0.f};
    if constexpr (Epi::INIT) E.init(acc, cur, wr, wc, fr, fq);
    bf16x8 At[4][2], B0[2][2], B1[2][2];
    const char* cA = (const char*)g.A + (size_t)cur.pm * tstep; const char* cB = (const char*)g.Bt + (size_t)cur.pn * tstep;
    S.a_ready(cur);
    if constexpr (SP2) {
        PG8_STAGE(PG8_SB(0, 0), cB, voffB); PG8_STAGE(PG8_SB(0, 1), cB + hstep, voffB); PG8_STAGE(PG8_SA(0, 0), cA, voffA); PG8_STAGE(PG8_SA(0, 1), cA + hstep, voffA);
        if (wr == 1) PG8_BAR;
        PG8_WAIT_V(2); PG8_BAR;
        PG8_STAGE(PG8_SB(1, 0), cB + kstep, voffB); PG8_STAGE(PG8_SA(1, 0), cA + kstep, voffA); PG8_STAGE(PG8_SB(1, 1), cB + hstep + kstep, voffB);
        PG8_WAIT_V(6); PG8_BAR;
    } else {
        PG8_STAGE(PG8_SB(0, 0), cB, voffB); PG8_STAGE(PG8_SA(0, 0), cA, voffA); PG8_STAGE(PG8_SB(0, 1), cB + hstep, voffB); PG8_STAGE(PG8_SA(0, 1), cA + hstep, voffA);
        if (wr == 1) PG8_BAR;
        PG8_WAIT_V(4); PG8_BAR;
        PG8_STAGE(PG8_SB(1, 0), cB + kstep, voffB); PG8_STAGE(PG8_SA(1, 0), cA + kstep, voffA); PG8_STAGE(PG8_SB(1, 1), cB + hstep + kstep, voffB);
        PG8_WAIT_V(6); PG8_BAR;
    }
    for (;;) {
        const bool has_next = S.next(ui + 1, nxt);
        const char* nA = has_next ? (const char*)g.A + (size_t)nxt.pm * tstep : cA; const char* nB = has_next ? (const char*)g.Bt + (size_t)nxt.pn * tstep : cB;
        for (int t = 0; t < nt; t += 2) {
            const bool last = (t == nt - 2);
            const char* a1 = cA + (size_t)(t + 1) * kstep;
            const char* a2 = last ? nA : cA + (size_t)(t + 2) * kstep; const char* b2 = last ? nB : cB + (size_t)(t + 2) * kstep;
            const char* a3 = a2 + kstep; const char* b3 = b2 + kstep;
            if (last && has_next) S.a_ready(nxt);
            if constexpr (SP2) {
            PG8_LDB(B0, 0, 0); PG8_LDB(B1, 0, 1); PG8_SCHED; PG8_LDA(At, 0, 0); PG8_STAGE(PG8_SA(1, 1), a1 + hstep, voffA);
            PG8_WAIT_V(8); PG8_WAIT_L(0); PG8_BAR; PG8_MMA(0, 0, At, B0); PG8_MMA(0, 1, At, B1); PG8_BAR; PG8_SCHED;
            PG8_LDA(At, 0, 1); PG8_STAGE(PG8_SB(0, 0), b2, voffB); PG8_STAGE(PG8_SB(0, 1), b2 + hstep, voffB); PG8_STAGE(PG8_SA(0, 0), a2, voffA);
            PG8_WAIT_V(8); PG8_WAIT_L(0); PG8_BAR; PG8_MMA(1, 0, At, B0); PG8_MMA(1, 1, At, B1); PG8_BAR; PG8_SCHED;
            PG8_LDB(B0, 1, 0); PG8_LDB(B1, 1, 1); PG8_SCHED; PG8_LDA(At, 1, 0); PG8_STAGE(PG8_SA(0, 1), a2 + hstep, voffA);
            PG8_WAIT_V(8); PG8_WAIT_L(0); PG8_BAR; PG8_MMA(0, 0, At, B0); PG8_MMA(0, 1, At, B1); PG8_BAR; PG8_SCHED;
            PG8_LDA(At, 1, 1); PG8_STAGE(PG8_SB(1, 0), b3, voffB); PG8_STAGE(PG8_SB(1, 1), b3 + hstep, voffB); PG8_STAGE(PG8_SA(1, 0), a3, voffA);
            PG8_WAIT_V(8); PG8_WAIT_L(0); PG8_BAR; PG8_MMA(1, 0, At, B0); PG8_MMA(1, 1, At, B1); PG8_BAR; PG8_SCHED;
            } else {
            PG8_LDB(B0, 0, 0); PG8_SCHED; PG8_LDA(At, 0, 0); PG8_STAGE(PG8_SA(1, 1), a1 + hstep, voffA);
            PG8_WAIT_L(8); PG8_BAR; PG8_WAIT_L(0); PG8_MMA(0, 0, At, B0); PG8_BAR; PG8_SCHED;
            PG8_LDB(B1, 0, 1); PG8_STAGE(PG8_SB(0, 0), b2, voffB);
            PG8_BAR; PG8_WAIT_L(0); PG8_MMA(0, 1, At, B1); PG8_BAR;
            PG8_LDA(At, 0, 1); PG8_STAGE(PG8_SA(0, 0), a2, voffA);
            PG8_BAR; PG8_WAIT_L(0); PG8_MMA(1, 0, At, B0); PG8_BAR; PG8_SCHED;
            PG8_STAGE(PG8_SB(0, 1), b2 + hstep, voffB);
            PG8_WAIT_V(6); PG8_BAR; PG8_MMA(1, 1, At, B1); PG8_BAR;
            PG8_LDB(B0, 1, 0); PG8_SCHED; PG8_LDA(At, 1, 0); PG8_STAGE(PG8_SA(0, 1), a2 + hstep, voffA);
            PG8_WAIT_L(8); PG8_BAR; PG8_WAIT_L(0); PG8_MMA(0, 0, At, B0); PG8_BAR; PG8_SCHED;
            PG8_LDB(B1, 1, 1); PG8_STAGE(PG8_SB(1, 0), b3, voffB);
            PG8_BAR; PG8_WAIT_L(0); PG8_MMA(0, 1, At, B1); PG8_BAR;
            PG8_LDA(At, 1, 1); PG8_STAGE(PG8_SA(1, 0), a3, voffA);
            PG8_BAR; PG8_WAIT_L(0); PG8_MMA(1, 0, At, B0); PG8_BAR; PG8_SCHED;
            PG8_STAGE(PG8_SB(1, 1), b3 + hstep, voffB);
            PG8_WAIT_V(6); PG8_BAR; PG8_MMA(1, 1, At, B1); PG8_BAR;
            }
        }
        if constexpr (ALIGN_EPI) { if (wr == 0) PG8_BAR; }
        if constexpr (!Epi::AFTER_DRAIN) { E(acc, cur, wr, wc, fr, fq); S.done(cur); }
        if (!has_next) break;
#pragma unroll
        for (int a = 0; a < 2; ++a)
#pragma unroll
            for (int b = 0; b < 2; ++b)
#pragma unroll
                for (int m = 0; m < 4; ++m)
#pragma unroll
                    for (int n = 0; n < 2; ++n) acc[a][b][m][n] = (f32x4){0.f, 0.f, 0.f, 0.f};
        if constexpr (Epi::INIT) E.init(acc, nxt, wr, wc, fr, fq);
        cur = nxt; cA = nA; cB = nB; ++ui;
        if constexpr (ALIGN_EPI) { if (wr == 1) PG8_BAR; }
    }
    PG8_WAIT_V(0);
    if constexpr (!ALIGN_EPI) { if (wr == 0) PG8_BAR; }
    PG8_BAR;
    if constexpr (Epi::AFTER_DRAIN) { E.fused(acc, cur, wr, wc, fr, fq, lds, wid, lane); S.done(cur); }
#undef PG8_SA
#undef PG8_SB
#undef PG8_STAGE
#undef PG8_LDA
#undef PG8_LDB
#undef PG8_MMA
#undef PG8_WAIT_V
#undef PG8_WAIT_L
#undef PG8_BAR
#undef PG8_SCHED
}
}

#define LAS __attribute__((address_space(3)))
using pg8::bf16_t; using pg8::bf16x8; using pg8::f32x4; using pg8::u32x4; using pg8::u32x2;
typedef float f32x16 __attribute__((ext_vector_type(16)));
constexpr int NWAVES = 8, NTHR = 512;
constexpr int LDS_BYTES = 147456;

constexpr size_t MiB = 1u << 20;
constexpr size_t WS_ROPEA = 0, WS_ROPEB = 262144, WS_CTL = 800 * 1024, CTL_BYTES = 65536;
constexpr size_t WS_WIN = 1 * MiB;
constexpr size_t WS_WDV = WS_WIN + (size_t)1792 * 1024 * 2;
constexpr size_t WS_WQ = WS_WDV + (size_t)512 * 1024 * 2;
constexpr size_t WS_WK = WS_WQ + (size_t)768 * 384 * 2;
constexpr size_t WS_WV = WS_WK + (size_t)512 * 256 * 2;
constexpr size_t WS_WO = WS_WV + (size_t)512 * 256 * 2;
constexpr size_t WS_WGU = WS_WO + (size_t)1024 * 1024 * 2;
constexpr size_t WS_WD = WS_WGU + (size_t)5632 * 1024 * 2;
static_assert(WS_WD + (size_t)1024 * 2816 * 2 <= 26 * MiB, "weights");
constexpr size_t WS_SSQQ = 26 * MiB, WS_SSQKV = 26 * MiB + 524288, WS_SSQX = 27 * MiB;
constexpr size_t WS_H = 28 * MiB;
constexpr size_t WS_CQ = 60 * MiB, WS_CKV = 72 * MiB, WS_QA = 80 * MiB, WS_KA = 104 * MiB, WS_VTA = 128 * MiB;
constexpr size_t WS_ABUF = 60 * MiB;
constexpr size_t WS_QD = 148 * MiB, WS_KD = 164 * MiB, WS_VTD = 180 * MiB, WS_O = 196 * MiB, WS_HL = 228 * MiB;
static_assert(WS_ABUF + (size_t)M * FF * 2 <= WS_QD && WS_HL + (size_t)256 * 6 * FF * 4 <= 256 * MiB, "d_ws map");

struct Params {
    const float* in[23]; float* out; unsigned char* ws;
    float invA[16]; float invB[32];
    int ph_lo, ph_hi;
};

__device__ __forceinline__ float wave_sum(float v) {
#pragma unroll
    for (int o = 1; o < 64; o <<= 1) v += shx(v, o);
    return v;
}
__device__ __forceinline__ unsigned pk2(float lo, float hi) { return pg8::cvt_pk_bf16(lo, hi); }

__device__ __forceinline__ void p0_transpose_item(const float* W, int ldw, int K, bf16_t* WT, int drow0, const float* gain, LAS float* scr, int k0, int n0, int lane) {
#pragma unroll 8
    for (int i = 0; i < 32; ++i) { const int kk = 2 * i + (lane >> 5); float v = W[(size_t)(k0 + kk) * ldw + n0 + (lane & 31)]; if (gain) v *= gain[k0 + kk]; scr[kk * 33 + (lane & 31)] = v; }
    asm volatile("s_waitcnt lgkmcnt(0)" ::: "memory");
    const int c = lane & 7;
#pragma unroll
    for (int j = 0; j < 4; ++j) { const int n = (lane >> 3) + 8 * j; const LAS float* s = scr + (8 * c) * 33 + n;
        u32x4 o; o.x = pk2(s[0 * 33], s[1 * 33]); o.y = pk2(s[2 * 33], s[3 * 33]); o.z = pk2(s[4 * 33], s[5 * 33]); o.w = pk2(s[6 * 33], s[7 * 33]);
        *(u32x4*)(WT + (size_t)(drow0 + n) * K + k0 + 8 * c) = o; }
    asm volatile("s_waitcnt lgkmcnt(0)" ::: "memory");
}

__device__ __forceinline__ void convert_items(const Params& p, LAS unsigned char* lds, int it0, int it1, int gw, int NGW, int wave, int lane) {
    unsigned char* ws = p.ws;
    LAS float* scr = (LAS float*)(lds + wave * 16384);
    bf16_t* Win = (bf16_t*)(ws + WS_WIN); bf16_t* Wdv = (bf16_t*)(ws + WS_WDV); bf16_t* Wq = (bf16_t*)(ws + WS_WQ); bf16_t* Wk = (bf16_t*)(ws + WS_WK);
    bf16_t* Wv = (bf16_t*)(ws + WS_WV); bf16_t* Wo = (bf16_t*)(ws + WS_WO); bf16_t* Wgu = (bf16_t*)(ws + WS_WGU); bf16_t* Wd = (bf16_t*)(ws + WS_WD);
    constexpr int I_IN = 16 * 69, I_Q = 6 * 24, I_KV = 4 * 32, I_O = 16 * 32, I_G = 16 * 88, I_D = 44 * 32;
    constexpr int NITEMS = I_IN + I_Q + I_KV + I_O + 2 * I_G + I_D;
    for (int it = it0 + gw; it < it1; it += NGW) {
        int r = it;
        if (r < I_IN) { const int kb = r / 69, nb = r % 69, n0 = nb * 32;
            if (n0 < 1696) { const int L = (n0 < 384) ? n0 : (n0 < 640) ? 512 + (n0 - 384) : (n0 < 672) ? 384 + (n0 - 640) : (n0 < 1184) ? 768 + (n0 - 672) : 1280 + (n0 - 1184);
                const int T = L >> 8, l = L & 255, g = l >> 6, bj = (l >> 5) & 1;
                p0_transpose_item(p.in[2], 2208, 1024, Win, 256 * T + 128 * bj + 32 * g, nullptr, scr, kb * 64, n0, lane); }
            else p0_transpose_item(p.in[2], 2208, 1024, Wdv, n0 - 1696, nullptr, scr, kb * 64, n0, lane);
            continue; }
        r -= I_IN;
        if (r < I_Q) { const int kb = r / 24, nb = r % 24, n0 = nb * 32, h = n0 / 96, blk = (n0 % 96) / 32;
            const int wsl = (blk < 2) ? h : 8 + (h >> 1), bj = (blk < 2) ? blk : (h & 1);
            p0_transpose_item(p.in[4], 768, 384, Wq, 256 * (wsl >> 2) + 128 * bj + 32 * (wsl & 3), p.in[3], scr, kb * 64, n0, lane); continue; }
        r -= I_Q;
        if (r < I_KV) { const int kb = r / 32, nb = r % 32, n0 = nb * 32, h = n0 >> 7, c0 = n0 & 127;
            if (c0 < 64) p0_transpose_item(p.in[6], 1024, 256, Wk, 256 * (h >> 2) + 128 * (c0 >> 5) + 32 * (h & 3), p.in[5], scr, kb * 64, n0, lane);
            else p0_transpose_item(p.in[6], 1024, 256, Wv, h * 64 + (c0 - 64), p.in[5], scr, kb * 64, n0, lane);
            continue; }
        r -= I_KV;
        if (r < I_O) { const int kb = r / 32, nb = r % 32; p0_transpose_item(p.in[16], 1024, 1024, Wo, nb * 32, nullptr, scr, kb * 64, nb * 32, lane); continue; }
        r -= I_O;
        if (r < 2 * I_G) { const int up = r >= I_G; if (up) r -= I_G; const int kb = r / 88, nb = r % 88, f0 = nb * 32;
            p0_transpose_item(p.in[up ? 19 : 18], FF, 1024, Wgu, 256 * (f0 >> 7) + 128 * up + 32 * ((f0 >> 5) & 3), p.in[17], scr, kb * 64, f0, lane); continue; }
        r -= 2 * I_G;
        { const int kb = r / 32, nb = r % 32; p0_transpose_item(p.in[22], 1024, FF, Wd, nb * 32, nullptr, scr, kb * 64, nb * 32, lane); }
    }
}
constexpr int CONV_EARLY = 16 * 69 + 6 * 24 + 4 * 32, CONV_ALL = CONV_EARLY + 16 * 32 + 2 * 16 * 88 + 44 * 32;
__device__ __forceinline__ void p0_prologue(const Params& p, LAS unsigned char* lds, int vcu, int G, int wave, int lane) {
    unsigned char* ws = p.ws;
    const int gw = vcu * NWAVES + wave, NGW = G * NWAVES;
    bf16_t* Win = (bf16_t*)(ws + WS_WIN);
    convert_items(p, lds, 0, CONV_ALL, gw, NGW, wave, lane);
    for (int i = gw * 64 + lane; i < 96 * 128; i += NGW * 64) { const int rr = i >> 7, c = i & 127; const int row = 256 + (rr < 32 ? 352 - 256 + rr : 448 - 256 + (rr - 32)); *(u32x4*)(Win + (size_t)row * 1024 + c * 8) = (u32x4){0u, 0u, 0u, 0u}; }
    float* ropeA = (float*)(ws + WS_ROPEA); float* ropeB = (float*)(ws + WS_ROPEB);
    for (int i = gw * 64 + lane; i < SEQ * 48; i += NGW * 64) {
        const bool isA = i < SEQ * 16; const int e = isA ? i : i - SEQ * 16; const int s = isA ? e >> 4 : e >> 5, k = isA ? e & 15 : e & 31;
        const float ang = (float)s * (isA ? p.invA[k] : p.invB[k]);
        const double rev = (double)ang * 0.15915494309189535; const float fr = (float)(rev - floor(rev));
        const float sn = __builtin_amdgcn_sinf(fr), cs = __builtin_amdgcn_cosf(fr);
        float* dst = (isA ? ropeA : ropeB) + (size_t)e * 2; dst[0] = cs; dst[1] = sn;
    }
    bf16_t* H = (bf16_t*)(ws + WS_H); const float* x = p.in[0]; const float* g = p.in[1];
    f32x4 gv[4];
#pragma unroll
    for (int j = 0; j < 4; ++j) gv[j] = *(const f32x4*)(g + 4 * lane + 256 * j);
    for (int m = gw; m < M; m += NGW) {
        const f32x4* xr = (const f32x4*)(x + (size_t)m * DM) + lane; f32x4 v[4]; float s = 0.f;
#pragma unroll
        for (int j = 0; j < 4; ++j) { v[j] = xr[64 * j]; s += pg8::dot4(v[j]); }
        const float rstd = rsqrtf(wave_sum(s) * (1.f / DM) + EPS);
        unsigned long long* o8 = (unsigned long long*)(H + (size_t)m * DM) + lane;
#pragma unroll
        for (int j = 0; j < 4; ++j) { const f32x4 y = v[j] * gv[j] * rstd; o8[64 * j] = (unsigned long long)pk2(y[0], y[1]) | ((unsigned long long)pk2(y[2], y[3]) << 32); }
    }
}

struct AttnP { const bf16_t *Qa, *Kn, *Kpe, *Vta, *Qd, *Kd, *Vtd; bf16_t* O; const float* subln_g; };
__device__ __forceinline__ bf16x8 packp(const f32x16& p, int b) {
    u32x4 w; w.x = pk2(p[b], p[b + 1]); w.y = pk2(p[b + 2], p[b + 3]); w.z = pk2(p[b + 4], p[b + 5]); w.w = pk2(p[b + 6], p[b + 7]);
    return __builtin_bit_cast(bf16x8, w);
}
template <bool DIFF> __device__ __forceinline__ void attn_unit(LAS unsigned char* lds, const AttnP& P, int b, int h, int qb, float lam, const int wave_s, const int VAR = 0) {
    constexpr int DQK = DIFF ? 64 : 96, DV = DIFF ? 128 : 64, QROWS = DIFF ? 128 : 256, NDB = DV / 32, NS = DQK / 16;
    constexpr int STAGE = DIFF ? 32768 : 20480, V_OFF = DIFF ? 16384 : 12288, NSLOT = 4;
    static_assert(NSLOT * STAGE <= 131072 && 4 * 128 * 32 * 4 <= NSLOT * STAGE + 32768, "attention LDS");
    int tid_ = wave_s * 64 + lane_fresh(); asm volatile("" : "+v"(tid_));
    const int tid = tid_, lane = tid & 63, wid = __builtin_amdgcn_readfirstlane(tid >> 6), r32 = lane & 31, hi = lane >> 5;
    const int map = DIFF ? (wid >> 2) : 0, wq = DIFF ? (wid & 3) : wid;
    const int q0 = qb * QROWS, qw_min = q0 + 32 * wq, qrow = qw_min + r32;
    const size_t mrow0 = (size_t)b * SEQ;
    const bf16_t* Qp = DIFF ? P.Qd + (mrow0 + qrow) * 512 + h * 128 + map * 64 : P.Qa + (mrow0 + qrow) * 768 + h * 96;
    bf16x8 qf[NS];
#pragma unroll
    for (int s = 0; s < NS; ++s) qf[s] = *(const bf16x8*)(Qp + 16 * s + 8 * hi);
    const int NT = (VAR & 16) ? 2 : (q0 + QROWS) / 64;
    const char* src[4]; int dsto[4]; int strd[4]; int nops;
    if (DIFF) {
        nops = 4;
#pragma unroll
        for (int i = 0; i < 2; ++i) { const int j = wid + 8 * i, row = 4 * j + (lane >> 4), c = (lane & 15) ^ (row & 15);
            src[i] = (const char*)(P.Kd + (mrow0 + row) * 512 + h * 128 + c * 8); dsto[i] = j * 1024; strd[i] = 65536; }
#pragma unroll
        for (int i = 0; i < 2; ++i) { const int j = wid + 8 * i, d = 8 * j + (lane >> 3), c = (lane & 7) ^ ((d >> 1) & 7);
            src[2 + i] = (const char*)(P.Vtd + (size_t)(h * 128 + d) * M + mrow0 + c * 8); dsto[2 + i] = V_OFF + j * 1024; strd[2 + i] = 128; }
    } else {
        nops = wid < 4 ? 3 : 2;
        { const int row = 8 * wid + (lane >> 3), c = (lane & 7) ^ ((row >> 1) & 7);
          src[0] = (const char*)(P.Kn + (mrow0 + row) * 512 + h * 64 + c * 8); dsto[0] = wid * 1024; strd[0] = 65536; }
        const int jv1 = wid < 4 ? wid + 4 : wid - 4;
        const int dv_ = 8 * jv1 + (lane >> 3), cv_ = (lane & 7) ^ ((dv_ >> 1) & 7);
        const char* vsrc = (const char*)(P.Vta + (size_t)(h * 64 + dv_) * M + mrow0 + cv_ * 8);
        const int prow = 16 * (wid & 3) + (lane >> 2), pc = (lane & 3) ^ ((prow >> 2) & 3);
        const char* psrc = (const char*)(P.Kpe + (mrow0 + prow) * 32 + pc * 8);
        if (wid < 4) { src[1] = psrc; dsto[1] = 8192 + wid * 1024; strd[1] = 4096; src[2] = vsrc; dsto[2] = V_OFF + jv1 * 1024; strd[2] = 128; }
        else { src[1] = vsrc; dsto[1] = V_OFF + jv1 * 1024; strd[1] = 128; src[2] = vsrc; dsto[2] = 0; strd[2] = 0; }
        src[3] = vsrc; dsto[3] = 0; strd[3] = 0;
    }
#define ATT_DMA(t, slot) do { if (!(VAR & 1)) _Pragma("unroll") for (int i_ = 0; i_ < 4; ++i_) if (i_ < nops) \
        __builtin_amdgcn_global_load_lds((const unsigned*)(src[i_] + (size_t)(t) * strd[i_]), (LAS unsigned*)(lds + (slot) * STAGE + dsto[i_]), 16, 0, 0); } while (0)
    const int x16 = r32 & 15, pi = (r32 & 16) + ((x16 < 4 || x16 >= 12) ? x16 : (x16 < 8 ? x16 + 4 : x16 - 4));
    int kaddr[NS], vaddr[4];
#pragma unroll
    for (int s = 0; s < NS; ++s) {
        if (DIFF) kaddr[s] = pi * 256 + (((8 * map + 2 * s + hi) ^ (pi & 15)) << 4);
        else if (s < 4) kaddr[s] = pi * 128 + (((2 * s + hi) ^ ((pi >> 1) & 7)) << 4);
        else kaddr[s] = 8192 + pi * 64 + (((2 * (s - 4) + hi) ^ ((pi >> 2) & 3)) << 4);
    }
#pragma unroll
    for (int a = 0; a < 4; ++a) vaddr[a] = V_OFF + r32 * 128 + (((2 * a + hi) ^ ((r32 >> 1) & 7)) << 4);
    f32x16 o[NDB];
#pragma unroll
    for (int d = 0; d < NDB; ++d)
#pragma unroll
        for (int r = 0; r < 16; ++r) o[d][r] = 0.f;
    float mref = 0.f, lsum = 0.f;
    f32x16 negm;
#pragma unroll
    for (int r = 0; r < 16; ++r) negm[r] = 0.f;
    __builtin_amdgcn_s_waitcnt(0);
    ATT_DMA(0, 0); ATT_DMA(1, 1);
#define SBAR() __builtin_amdgcn_sched_barrier(0)
#define MX3(a, b, c) __builtin_fmaxf(__builtin_fmaxf((a), (b)), (c))
#define ATT_WAIT(t) do { if (VAR & 1) {} else if ((t) + 1 < NT) { if (DIFF) asm volatile("s_waitcnt vmcnt(4)" ::: "memory"); else if (wid < 4) asm volatile("s_waitcnt vmcnt(3)" ::: "memory"); else asm volatile("s_waitcnt vmcnt(2)" ::: "memory"); } \
        else asm volatile("s_waitcnt vmcnt(0)" ::: "memory"); if (!(VAR & 4)) __builtin_amdgcn_s_barrier(); asm volatile("" ::: "memory"); } while (0)
#define ATT_QK(P0, P1, kb) do { _Pragma("unroll") for (int s = 0; s < NS; ++s) { const int pbo = DIFF ? 8192 : (s < 4 ? 4096 : 2048); \
            const bf16x8 k0 = *(const LAS bf16x8*)((kb) + kaddr[s]), k1 = *(const LAS bf16x8*)((kb) + kaddr[s] + pbo); \
            if (s == 0) { if (DIFF) { f32x16 z; _Pragma("unroll") for (int r = 0; r < 16; ++r) z[r] = 0.f; P0 = __builtin_amdgcn_mfma_f32_32x32x16_bf16(k0, qf[0], z, 0, 0, 0); P1 = __builtin_amdgcn_mfma_f32_32x32x16_bf16(k1, qf[0], z, 0, 0, 0); } \
                          else { P0 = __builtin_amdgcn_mfma_f32_32x32x16_bf16(k0, qf[0], negm, 0, 0, 0); P1 = __builtin_amdgcn_mfma_f32_32x32x16_bf16(k1, qf[0], negm, 0, 0, 0); } } \
            else { P0 = __builtin_amdgcn_mfma_f32_32x32x16_bf16(k0, qf[s], P0, 0, 0, 0); P1 = __builtin_amdgcn_mfma_f32_32x32x16_bf16(k1, qf[s], P1, 0, 0, 0); } } } while (0)
#define ATT_MASK(P0, P1, t) do { if (64 * (t) + 63 > qw_min) { const int kv0 = 64 * (t) + 8 * hi; \
            _Pragma("unroll") for (int r = 0; r < 16; ++r) { const int kv = kv0 + 16 * (r >> 3) + (r & 7); if (kv > qrow) P0[r] = -INFINITY; if (kv + 32 > qrow) P1[r] = -INFINITY; } } } while (0)
#define ATT_ROWMAX(rm, P0, P1) do { float ma = MX3(P0[0], P0[1], P1[0]), mb = MX3(P0[2], P0[3], P1[1]); ma = MX3(ma, P1[2], P1[3]); \
            _Pragma("unroll") for (int r = 4; r < 16; r += 4) { ma = MX3(ma, P0[r], P0[r + 1]); mb = MX3(mb, P0[r + 2], P0[r + 3]); ma = MX3(ma, P1[r], P1[r + 1]); mb = MX3(mb, P1[r + 2], P1[r + 3]); } \
            rm = fmaxf(ma, mb); rm = fmaxf(rm, shx(rm, 32)); } while (0)
#define ATT_SUB(P0, P1, v) do { const pg8::f32x2 m2_ = {(v), (v)}; _Pragma("unroll") for (int r = 0; r < 16; r += 2) { pg8::f32x2 a_ = {P0[r], P0[r + 1]}, b_ = {P1[r], P1[r + 1]}; a_ -= m2_; b_ -= m2_; P0[r] = a_[0]; P0[r + 1] = a_[1]; P1[r] = b_[0]; P1[r + 1] = b_[1]; } } while (0)
#define ATT_EXP(P0, P1) do { if (!(VAR & 2)) _Pragma("unroll") for (int r = 0; r < 16; ++r) { P0[r] = __builtin_amdgcn_exp2f(P0[r]); P1[r] = __builtin_amdgcn_exp2f(P1[r]); } } while (0)
#define ATT_SUMPACK(P0, P1) do { pg8::f32x2 s2 = {0.f, 0.f}; _Pragma("unroll") for (int r = 0; r < 16; r += 2) { s2 += (pg8::f32x2){P0[r], P0[r + 1]}; s2 += (pg8::f32x2){P1[r], P1[r + 1]}; } lsum += s2[0] + s2[1]; \
            pk[0] = packp(P0, 0); pk[1] = packp(P0, 8); pk[2] = packp(P1, 0); pk[3] = packp(P1, 8); } while (0)
#define ATT_PV(kb) do { if (!(VAR & 8)) _Pragma("unroll") for (int d = 0; d < NDB; ++d) _Pragma("unroll") for (int a = 0; a < 4; ++a) { \
            const bf16x8 vf = *(const LAS bf16x8*)((kb) + vaddr[a] + d * 4096); o[d] = __builtin_amdgcn_mfma_f32_32x32x16_bf16(vf, pk[a], o[d], 0, 0, 0); } } while (0)
    f32x16 pa0, pa1, pb0, pb1; bf16x8 pk[4];
    ATT_WAIT(0);
    if (2 < NT) ATT_DMA(2, 2);
    { ATT_QK(pa0, pa1, lds); ATT_MASK(pa0, pa1, 0); float rm; ATT_ROWMAX(rm, pa0, pa1); mref = rm; ATT_SUB(pa0, pa1, rm);
      if (!DIFF) { _Pragma("unroll") for (int r = 0; r < 16; ++r) negm[r] = -mref; }
      ATT_EXP(pa0, pa1); }
    float fpend = 1.f; bool rpend = false;
    for (int t = 1; t < NT; ++t) {
        ATT_WAIT(t);
        if (t + 2 < NT) ATT_DMA(t + 2, (t + 2) & 3);
        const LAS unsigned char* kc = lds + (t & 3) * STAGE; const LAS unsigned char* kp = lds + ((t - 1) & 3) * STAGE;
        if (rpend) {
#pragma unroll
            for (int d = 0; d < NDB; ++d)
#pragma unroll
                for (int r = 0; r < 16; ++r) o[d][r] *= fpend;
        }
        SBAR();
        ATT_QK(pb0, pb1, kc);
        ATT_SUMPACK(pa0, pa1);
#pragma unroll
        for (int i_ = 0; i_ < 2 * NS; ++i_) { __builtin_amdgcn_sched_group_barrier(0x100, 1, 0); __builtin_amdgcn_sched_group_barrier(0x008, 1, 0); __builtin_amdgcn_sched_group_barrier(0x002, DIFF ? 5 : 3, 0); }
        SBAR();
        ATT_MASK(pb0, pb1, t);
        float rm; ATT_ROWMAX(rm, pb0, pb1);
        float f = 1.f; bool resc;
        if (DIFF) { const float rel = rm - mref; resc = __any(rel > 8.0f); if (resc) { const float dl = fmaxf(rel, 0.f); f = __builtin_amdgcn_exp2f(-dl); mref += dl; lsum *= f; } ATT_SUB(pb0, pb1, mref); }
        else { resc = __any(rm > 8.0f); if (resc) { const float dl = fmaxf(rm, 0.f); f = __builtin_amdgcn_exp2f(-dl); mref += dl; lsum *= f; ATT_SUB(pb0, pb1, dl); _Pragma("unroll") for (int r = 0; r < 16; ++r) negm[r] = -mref; } }
        SBAR();
        ATT_PV(kp);
        ATT_EXP(pb0, pb1);
#pragma unroll
        for (int i_ = 0; i_ < 4 * NDB; ++i_) { __builtin_amdgcn_sched_group_barrier(0x100, 1, 0); __builtin_amdgcn_sched_group_barrier(0x008, 1, 0); __builtin_amdgcn_sched_group_barrier(0x002, DIFF ? 2 : 4, 0); }
        SBAR();
        rpend = resc; fpend = f;
        pa0 = pb0; pa1 = pb1;
    }
    if (rpend) {
#pragma unroll
        for (int d = 0; d < NDB; ++d)
#pragma unroll
            for (int r = 0; r < 16; ++r) o[d][r] *= fpend;
    }
    { ATT_SUMPACK(pa0, pa1); ATT_PV(lds + ((NT - 1) & 3) * STAGE); }
#undef ATT_DMA
#undef ATT_WAIT
#undef ATT_QK
#undef ATT_MASK
#undef ATT_ROWMAX
#undef ATT_SUB
#undef ATT_EXP
#undef ATT_SUMPACK
#undef ATT_PV
#undef MX3
#undef SBAR
    asm volatile("s_waitcnt lgkmcnt(0)" ::: "memory"); __builtin_amdgcn_s_barrier(); asm volatile("" ::: "memory");
    const float inv = 1.f / (lsum + shx(lsum, 32));
    if (!DIFF) {
        bf16_t* Op = P.O + (mrow0 + qrow) * 1024 + h * 64;
#pragma unroll
        for (int d = 0; d < NDB; ++d)
#pragma unroll
            for (int g = 0; g < 4; ++g) {
                u32x2 w; w.x = pk2(o[d][4 * g] * inv, o[d][4 * g + 1] * inv); w.y = pk2(o[d][4 * g + 2] * inv, o[d][4 * g + 3] * inv);
                *(u32x2*)(Op + 32 * d + 8 * g + 4 * hi) = w;
            }
    } else {
        LAS float* X = (LAS float*)lds;
        if (map == 1) {
#pragma unroll
            for (int d = 0; d < NDB; ++d)
#pragma unroll
                for (int r = 0; r < 16; ++r) { const int dd = 32 * d + (r & 3) + 8 * (r >> 2) + 4 * hi; X[(wq * 128 + dd) * 32 + r32] = o[d][r] * inv; }
        }
        asm volatile("s_waitcnt lgkmcnt(0)" ::: "memory"); __builtin_amdgcn_s_barrier(); asm volatile("" ::: "memory");
        if (map == 0) {
            float ss = 0.f;
#pragma unroll
            for (int d = 0; d < NDB; ++d)
#pragma unroll
                for (int r = 0; r < 16; ++r) { const int dd = 32 * d + (r & 3) + 8 * (r >> 2) + 4 * hi; const float v = o[d][r] * inv - lam * X[(wq * 128 + dd) * 32 + r32]; o[d][r] = v; ss += v * v; }
            ss += shx(ss, 32);
            const float rs = rsqrtf(ss * (1.f / 128.f) + EPS) * 0.8f;
            bf16_t* Op = P.O + (mrow0 + qrow) * 1024 + 512 + h * 128;
#pragma unroll
            for (int d = 0; d < NDB; ++d)
#pragma unroll
                for (int g = 0; g < 4; ++g) {
                    const int dd = 32 * d + 8 * g + 4 * hi; const f32x4 sg = *(const f32x4*)(P.subln_g + dd);
                    u32x2 w; w.x = pk2(o[d][4 * g] * rs * sg[0], o[d][4 * g + 1] * rs * sg[1]); w.y = pk2(o[d][4 * g + 2] * rs * sg[2], o[d][4 * g + 3] * rs * sg[3]);
                    *(u32x2*)(Op + dd) = w;
                }
        }
        asm volatile("s_waitcnt lgkmcnt(0)" ::: "memory"); __builtin_amdgcn_s_barrier(); asm volatile("" ::: "memory");
    }
}

#ifndef REP0
#define REP0 1
#endif
#ifndef REP1
#define REP1 1
#endif
#ifndef REP2
#define REP2 1
#endif
#ifndef REP3
#define REP3 1
#endif
#ifndef REP4
#define REP4 1
#endif
#ifndef REP5
#define REP5 1
#endif
#ifndef SKIP0
#define SKIP0 0
#endif
#ifndef SKIP1
#define SKIP1 0
#endif
#ifndef SKIP2
#define SKIP2 0
#endif
#ifndef SKIP3
#define SKIP3 0
#endif
#ifndef SKIP4
#define SKIP4 0
#endif
#ifndef SKIP5
#define SKIP5 0
#endif
#ifndef SKIP6
#define SKIP6 0
#endif
#ifndef SKIP7
#define SKIP7 0
#endif
#define XB_TMO      128
#define XB_XCNT(j)  (256  + 64 * (j))
#define XB_XSUB(j)  (1280 + 64 * (j))
#define XB_XGEN(j)  (2304 + 64 * (j))
#define XB_TOP      3328
#define XB_TOPGEN   3392
#define XCD_BAR_WORDS 3456
#define XB_SPIN_CAP (1u << 18)

__device__ __forceinline__ unsigned xb_ld(unsigned* p)              { return __hip_atomic_load(p, __ATOMIC_RELAXED, __HIP_MEMORY_SCOPE_AGENT); }
__device__ __forceinline__ unsigned xb_add(unsigned* p, unsigned v) { return __hip_atomic_fetch_add(p, v, __ATOMIC_RELAXED, __HIP_MEMORY_SCOPE_AGENT); }
__device__ __forceinline__ unsigned xb_xcc_id() { return (unsigned)__builtin_amdgcn_s_getreg((3 << 11) | 20) & 0xFu; }
#define XB_SPIN(cond, bar) do { unsigned _sp = 0; while (cond) { __builtin_amdgcn_s_sleep(1); \
    if ((++_sp & 255u) == 0u) { if (xb_ld(&(bar)[XB_TMO])) break; if (_sp > XB_SPIN_CAP) { atomicAdd(&(bar)[XB_TMO], 1u); break; } } } } while (0)

struct XcdBarrier {
    unsigned* bar; unsigned x;
    volatile LAS unsigned* st;
};

__device__ __forceinline__ XcdBarrier xcd_barrier_post(unsigned* bar, volatile LAS unsigned* st, bool t0) {
    XcdBarrier b; b.bar = bar; b.x = xb_xcc_id(); b.st = st;
    if (t0) (void)xb_add(&bar[XB_XCNT(b.x)], 1u);
    return b;
}
__device__ __forceinline__ void xcd_barrier_complete(unsigned* bar, unsigned x, unsigned& nloc, unsigned& nx) {
    const unsigned G = gridDim.x * gridDim.y * gridDim.z;
    unsigned sum, cnt, mine, sp = 0u;
    for (;;) {
        sum = 0u; cnt = 0u; mine = 0u;
#pragma unroll
        for (unsigned j = 0; j < 16; ++j) { const unsigned c = xb_ld(&bar[XB_XCNT(j)]); sum += c; cnt += (c > 0u) ? 1u : 0u; mine = (j == x) ? c : mine; }
        if (sum == G) break;
        __builtin_amdgcn_s_sleep(1);
        if ((++sp & 255u) == 0u) { if (xb_ld(&bar[XB_TMO])) break; if (sp > XB_SPIN_CAP) { atomicAdd(&bar[XB_TMO], 1u); break; } }
    }
    nloc = mine > 0u ? mine : 1u; nx = cnt > 0u ? cnt : 1u;
}

__device__ __forceinline__ void xcd_barrier(const XcdBarrier& b, bool t0) {
    asm volatile("s_waitcnt vmcnt(0)" ::: "memory");
    __syncthreads();
    if (t0) {
        unsigned* bar = b.bar;
        __builtin_amdgcn_s_waitcnt(0);
        unsigned nloc = b.st[0], nx = b.st[1];
        if (nloc == 0u) { xcd_barrier_complete(bar, b.x, nloc, nx); b.st[0] = nloc; b.st[1] = nx; }
        const unsigned old = xb_add(&bar[XB_XSUB(b.x)], 1u);
        const unsigned gen = old / nloc;
        if (old + 1u == (gen + 1u) * nloc) {
            __builtin_amdgcn_fence(__ATOMIC_RELEASE, "agent");
            asm volatile("s_waitcnt vmcnt(0)" ::: "memory");
            const unsigned og = xb_add(&bar[XB_TOP], 1u);
            const unsigned tg = og / nx;
            if (og + 1u == (tg + 1u) * nx) xb_add(&bar[XB_TOPGEN], 1u);
            else XB_SPIN(xb_ld(&bar[XB_TOPGEN]) == tg, bar);
            __builtin_amdgcn_fence(__ATOMIC_ACQUIRE, "agent");
            xb_add(&bar[XB_XGEN(b.x)], 1u);
            asm volatile("s_waitcnt vmcnt(0)" ::: "memory");
        } else {
            XB_SPIN(xb_ld(&bar[XB_XGEN(b.x)]) == gen, bar);
            __builtin_amdgcn_fence(__ATOMIC_ACQUIRE, "agent");
            asm volatile("s_waitcnt vmcnt(0)" ::: "memory");
        }
    }
    __syncthreads();
}

__global__ void __launch_bounds__(NTHR, 2) fwd_megakernel(Params p) {
    extern __shared__ __attribute__((aligned(16))) unsigned char lds_raw[];
    LAS unsigned char* lds = (LAS unsigned char*)lds_raw;
    cg::grid_group grid = cg::this_grid();
    const int G = gridDim.x, bx = blockIdx.x;
    const int wave_s = __builtin_amdgcn_readfirstlane((int)threadIdx.x >> 6);
#define FRESH_TID() (wave_s * 64 + lane_fresh())
    const int vcu = (G % 8 == 0) ? (bx % 8) * (G / 8) + bx / 8 : bx;
    unsigned char* ws = p.ws;
    const int lo = p.ph_lo, hi = p.ph_hi;
#define IN(k) (lo <= (k) && (k) < hi)
#define SEAM(k) do { if (IN(k) && IN((k) + 1)) { if (p.ph_hi == 0x7fffffff) grid.sync();   xcd_barrier(xbar, FRESH_TID() == 0); } } while (0)
    { const int t_ = FRESH_TID(); if (t_ < 2) ((volatile LAS unsigned*)(lds + 131072 + 8192))[t_] = 0u; }
    __syncthreads();
    XcdBarrier xbar; xbar.bar = (unsigned*)(ws + WS_CTL); xbar.x = 0; xbar.st = nullptr;
    if (hi - lo > 2) xbar = xcd_barrier_post((unsigned*)(ws + WS_CTL), (volatile LAS unsigned*)(lds + 131072 + 8192), FRESH_TID() == 0);
    bf16_t* H = (bf16_t*)(ws + WS_H);
    float* ropeA = (float*)(ws + WS_ROPEA); float* ropeB = (float*)(ws + WS_ROPEB);
    float* ssq_q = (float*)(ws + WS_SSQQ); float* ssq_x1 = (float*)(ws + WS_SSQX);
    bf16_t* CQ = (bf16_t*)(ws + WS_CQ); bf16_t* CKV = (bf16_t*)(ws + WS_CKV); bf16_t* Qa = (bf16_t*)(ws + WS_QA); bf16_t* Ka = (bf16_t*)(ws + WS_KA); bf16_t* Kpe = (bf16_t*)(ws + WS_KA + 16 * MiB); bf16_t* Vta = (bf16_t*)(ws + WS_VTA);
    bf16_t* Qd = (bf16_t*)(ws + WS_QD); bf16_t* Kd = (bf16_t*)(ws + WS_KD); bf16_t* Vtd = (bf16_t*)(ws + WS_VTD); bf16_t* O = (bf16_t*)(ws + WS_O);
    bf16_t* Abuf = (bf16_t*)(ws + WS_ABUF); float* HL = (float*)(ws + WS_HL);

    if (IN(0) && !SKIP0) for (int rep_ = 0; rep_ < REP0; ++rep_) { int t0_ = FRESH_TID(); asm volatile("" : "+v"(t0_)); p0_prologue(p, lds, vcu, G, __builtin_amdgcn_readfirstlane(t0_ >> 6), t0_ & 63); }
    SEAM(0);
    if (IN(1) && !SKIP1) for (int rep_ = 0; rep_ < REP1; ++rep_) {
        { pg8::Gemm g{H, (const bf16_t*)(ws + WS_WIN), M, 1792, 1024}; pg8::StaticOrder S; S.init(M, 1792, G, bx);
          pg8::EpiInProj E{CQ, CKV, Kpe, Qd, Kd, ssq_q, p.in[8], p.in[9], p.in[10], ropeA, ropeB, QSCALE_D, (LAS float*)(lds + 131072), (unsigned*)(ws + WS_CTL + 16384), (unsigned*)(ws + WS_CTL + 16384 + 64 * 256)};
          pg8::gemm_phase<pg8::EpiInProj, pg8::StaticOrder, true, true>(lds, g, S, E, wave_s); }
        { pg8::Gemm g{(const bf16_t*)(ws + WS_WDV), H, 512, M, 1024}; pg8::StaticOrder S; S.init(512, M, G, (bx + G - G / 2) % G);
          pg8::EpiStoreT E{Vtd, M};
          pg8::gemm_phase<pg8::EpiStoreT, pg8::StaticOrder, true, true>(lds, g, S, E, wave_s); }
    }
    if (IN(1) && !SKIP2) {
        unsigned* cntq = (unsigned*)(ws + WS_CTL + 16384); unsigned* cntkv = (unsigned*)(ws + WS_CTL + 16384 + 64 * 256);
#define PANEL_WAIT(cnt, pan, want) do { unsigned sp_ = 0; while (__hip_atomic_load((cnt) + 64 * (pan), __ATOMIC_RELAXED, __HIP_MEMORY_SCOPE_AGENT) < (want)) { __builtin_amdgcn_s_sleep(2); if (++sp_ > (1u << 22)) break; } \
        __builtin_amdgcn_fence(__ATOMIC_ACQUIRE, "workgroup"); asm volatile("" ::: "memory"); } while (0)
        { pg8::Gemm g{CQ, (const bf16_t*)(ws + WS_WQ), M, 768, 384}; pg8::StaticOrder S; S.init(M, 768, G, (bx + G / 4) % G);
          pg8::Unit u0; if (S.next(0, u0)) PANEL_WAIT(cntq, u0.pm, 16u);
          pg8::EpiQUp E{Qa, ssq_q, p.in[7], ropeA, QSCALE_A};
          pg8::gemm_phase<pg8::EpiQUp, pg8::StaticOrder, true, true>(lds, g, S, E, wave_s); }
        { pg8::Gemm g{CKV, (const bf16_t*)(ws + WS_WK), M, 512, 256}; pg8::StaticOrder S; S.init(M, 512, G, bx);
          pg8::Unit u0; if (S.next(0, u0)) PANEL_WAIT(cntkv, u0.pm, 8u);
          pg8::EpiKUp E{Ka, p.in[8]};
          pg8::gemm_phase<pg8::EpiKUp, pg8::StaticOrder, true, true>(lds, g, S, E, wave_s); }
        { pg8::Gemm g{(const bf16_t*)(ws + WS_WV), CKV, 512, M, 256}; pg8::StaticOrder S; S.init(512, M, G, (bx + G / 4) % G);
          pg8::Unit u0; if (S.next(0, u0)) PANEL_WAIT(cntkv, u0.pn, 8u);
          pg8::EpiStoreT E{Vta, M};
          pg8::gemm_phase<pg8::EpiStoreT, pg8::StaticOrder, true, true>(lds, g, S, E, wave_s); }
#undef PANEL_WAIT
    }
    do { if (IN(1) && IN(3)) { xcd_barrier(xbar, FRESH_TID() == 0); } } while (0);
    if (IN(3) && !SKIP3) for (int rep_ = 0; rep_ < REP3; ++rep_) {
        int t3_ = FRESH_TID(); asm volatile("" : "+v"(t3_)); const int lane = t3_ & 63;
        const float d1 = wave_sum(p.in[11][lane] * p.in[12][lane]), d2 = wave_sum(p.in[13][lane] * p.in[14][lane]);
        const float lam = __expf(d1) - __expf(d2) + 0.2f;
        AttnP P{Qa, Ka, Kpe, Vta, Qd, Kd, Vtd, O, p.in[15]};
#ifdef ATT_VAR
        const int avar = (rep_ == 0) ? ATT_VAR : 0;
#else
        const int avar = 0;
#endif
        for (int su = vcu; su < 256; su += G) {
            { const int bh = su >> 2, s = su & 3; attn_unit<false>(lds, P, bh >> 3, bh & 7, 7 - s, 0.f, wave_s, avar); attn_unit<false>(lds, P, bh >> 3, bh & 7, s, 0.f, wave_s, avar); }
            { const int bh = su >> 3, s = su & 7; attn_unit<true>(lds, P, bh >> 2, bh & 3, 15 - s, lam, wave_s, avar); attn_unit<true>(lds, P, bh >> 2, bh & 3, s, lam, wave_s, avar); }
        }
    }
    SEAM(3);
#ifdef EXTRA_BAR
    xcd_barrier(xbar, FRESH_TID() == 0); xcd_barrier(xbar, FRESH_TID() == 0); xcd_barrier(xbar, FRESH_TID() == 0); xcd_barrier(xbar, FRESH_TID() == 0);
#endif
    if (IN(4) && !SKIP4) for (int rep_ = 0; rep_ < REP4; ++rep_) {
        pg8::Gemm g{O, (const bf16_t*)(ws + WS_WO), M, 1024, 1024}; pg8::StaticOrder S; S.init(M, 1024, G, bx);
        pg8::EpiWOut E{p.in[0], p.out, H, ssq_x1};
        pg8::gemm_phase<pg8::EpiWOut, pg8::StaticOrder, true, true>(lds, g, S, E, wave_s);
    }
    SEAM(4);
    if (IN(5) && !SKIP5) for (int rep_ = 0; rep_ < REP5; ++rep_) {
        pg8::Gemm g{H, (const bf16_t*)(ws + WS_WGU), M, 2 * FF, 1024}; pg8::StaticOrder S; S.init(M, 2 * FF, G, bx);
        pg8::EpiGateUp E{Abuf, HL, ssq_x1, p.in[20], p.in[21]};
        pg8::gemm_phase<pg8::EpiGateUp, pg8::StaticOrder, true, true>(lds, g, S, E, wave_s);
    }
    SEAM(5);
    if (IN(6) && !SKIP6) {
        const float* cw = p.in[20]; const float* cb = p.in[21];
        int tid = FRESH_TID(); asm volatile("" : "+v"(tid));
        for (int i = bx * NTHR + tid; i < 256 * 2 * (FF / 4); i += G * NTHR) {
            const int f = (i % (FF / 4)) * 4, rr = (i / (FF / 4)) & 1, kb = i / (2 * (FF / 4));
            const bool first = (kb & 31) == 0;
            const f32x4 z = (f32x4){0.f, 0.f, 0.f, 0.f};
            const f32x4 gt = *(const f32x4*)(HL + ((size_t)kb * 6 + 2 + rr) * FF + f), ut = *(const f32x4*)(HL + ((size_t)kb * 6 + 4 + rr) * FF + f);
            const f32x4 p63 = first ? z : *(const f32x4*)(HL + ((size_t)(kb - 1) * 6 + 1) * FF + f);
            f32x4 gm1, gm2;
            if (rr == 0) { gm1 = p63; gm2 = first ? z : *(const f32x4*)(HL + ((size_t)(kb - 1) * 6 + 0) * FF + f); }
            else { gm1 = *(const f32x4*)(HL + ((size_t)kb * 6 + 2) * FF + f); gm2 = p63; }
            const f32x4 w0 = *(const f32x4*)(cw + f), w1 = *(const f32x4*)(cw + FF + f), w2 = *(const f32x4*)(cw + 2 * FF + f), b4 = *(const f32x4*)(cb + f);
            f32x4 o;
#pragma unroll
            for (int j = 0; j < 4; ++j) { const float cv = w2[j] * gt[j] + w1[j] * gm1[j] + w0[j] * gm2[j] + b4[j]; o[j] = cv / (1.f + __expf(-cv)) * ut[j]; }
            pg8::store8(Abuf + (size_t)(kb * 64 + rr) * FF + f, pg8::pack4(o));
        }
    }
    SEAM(6);
    if (IN(7) && !SKIP7) {
        pg8::Gemm g{Abuf, (const bf16_t*)(ws + WS_WD), M, 1024, FF}; pg8::StaticOrder S; S.init(M, 1024, G, bx);
#ifdef REP7
        { pg8::EpiDown E0{p.out, (float*)(ws + WS_QD)}; pg8::gemm_phase<pg8::EpiDown, pg8::StaticOrder, true, true>(lds, g, S, E0, wave_s); }
#endif
        pg8::EpiDown E{p.out, p.out};
        pg8::gemm_phase<pg8::EpiDown, pg8::StaticOrder, true, true>(lds, g, S, E, wave_s);
    }
#undef IN
#undef SEAM
}

#ifndef MK_N_LAUNCHES
#define MK_N_LAUNCHES 1
#endif
extern "C" void kernel_launch(void* const* d_in, const int* in_sizes, int n_in, void* d_out, int out_size, void* d_ws, size_t ws_size, hipStream_t stream) {
    static int grid = 0;
    if (grid == 0) {
        int dev = 0, cus = 0, per_cu = 0;
        hipGetDevice(&dev); hipDeviceGetAttribute(&cus, hipDeviceAttributeMultiprocessorCount, dev);
        hipFuncSetAttribute((const void*)fwd_megakernel, hipFuncAttributeMaxDynamicSharedMemorySize, LDS_BYTES);
        hipOccupancyMaxActiveBlocksPerMultiprocessor(&per_cu, (const void*)fwd_megakernel, NTHR, LDS_BYTES);
        (void)hipGetLastError();
        if (per_cu < 1) per_cu = 1;
        grid = cus * 1;
        if (grid <= 0) grid = 256;
    }
    Params p{};
    for (int i = 0; i < 23; ++i) p.in[i] = (const float*)d_in[i];
    p.out = (float*)d_out; p.ws = (unsigned char*)d_ws;
    for (int i = 0; i < 16; ++i) p.invA[i] = 1.0f / powf(10000.0f, (float)(2 * i) / 32.0f);
    for (int i = 0; i < 32; ++i) p.invB[i] = 1.0f / powf(10000.0f, (float)(2 * i) / 64.0f);
#if MK_N_LAUNCHES == 1
    p.ph_lo = 0; p.ph_hi = 8;
    hipMemsetAsync((char*)d_ws + WS_CTL, 0, CTL_BYTES, stream);
    void* args[] = {&p};
    hipError_t e = hipLaunchCooperativeKernel((const void*)fwd_megakernel, dim3(grid), dim3(NTHR), args, LDS_BYTES, stream);
    if (e != hipSuccess) fprintf(stderr, "cooperative launch failed: %s (grid %d)\n", hipGetErrorString(e), grid);
#else
    for (int ph = 0; ph < 8; ++ph) { p.ph_lo = ph; p.ph_hi = ph + 1; hipLaunchKernelGGL(fwd_megakernel, dim3(grid), dim3(NTHR), LDS_BYTES, stream, p); }
#endif
}
```

```cpp
#include <hip/hip_runtime.h>
#include <hip/hip_cooperative_groups.h>
#include <cstdio>
#include <cstdint>
#include <cmath>
namespace cg = cooperative_groups;

constexpr int BATCH = 8, SEQ = 2048, DM = 1024, M = BATCH * SEQ;
constexpr int FF = 2816;
constexpr float EPS = 1e-6f;
constexpr float LOG2E = 1.4426950408889634f;
constexpr float QSCALE_A = 0.10206207261596577f * LOG2E;
constexpr float QSCALE_D = 0.125f * LOG2E;

__device__ __forceinline__ int lane_fresh() { int l; asm volatile("v_mbcnt_lo_u32_b32 %0, -1, 0\n\tv_mbcnt_hi_u32_b32 %0, -1, %0" : "=v"(l)); return l; }
__device__ __forceinline__ float shx(float v, int mask) { const int idx = (lane_fresh() ^ mask) << 2; return __builtin_bit_cast(float, __builtin_amdgcn_ds_bpermute(idx, __builtin_bit_cast(int, v))); }
__device__ __forceinline__ float shl(float v, int src) { return __builtin_bit_cast(float, __builtin_amdgcn_ds_bpermute(src << 2, __builtin_bit_cast(int, v))); }
namespace pg8 {
#define PG8_LAS __attribute__((address_space(3)))
typedef unsigned short bf16_t;
typedef short bf16x8 __attribute__((ext_vector_type(8)));
typedef float f32x4 __attribute__((ext_vector_type(4)));
typedef unsigned u32x4 __attribute__((ext_vector_type(4)));
constexpr int BM = 256, BK = 64, HALF = 128, HTB = HALF * BK * 2  , STAGE_BYTES = 8 * HTB, NXCD = 8, WGM = 8;

__host__ __device__ __forceinline__ int lds_byte(int r, int c) { const int st = (r >> 4) * 2 + (c >> 5), rr = r & 15, cc = c & 31, ob = rr * 64 + cc * 2; return st * 1024 + (ob ^ (((ob >> 9) & 1) << 5)); }
__host__ __device__ __forceinline__ void stage_rc(int b, int& R, int& C) { const int st = b / 1024, sb = b % 1024, swz = sb ^ (((sb >> 9) & 1) << 5); R = (st >> 1) * 16 + swz / 64; C = (st & 1) * 32 + (swz % 64) / 2; }
__host__ __device__ __forceinline__ int perm32(int rho) { const int n = rho >> 4, i = rho & 15; return 8 * (i >> 2) + 4 * n + (i & 3); }

struct Unit { int pm, pn; };
struct Gemm { const bf16_t* A; const bf16_t* Bt; int M, N, K; };

struct StaticOrder {
    int nM, nN, nwg, G, c;
    __host__ __device__ void init(int M, int N, int G_, int c_) { nM = M / BM; nN = N / BM; nwg = nM * nN; G = G_; c = c_; }
    __host__ __device__ bool next(int i, Unit& u) const {
        const long L = (long)i * G + c; if (L >= nwg) return false;
        int wgid = (int)L; { const int q = nwg / NXCD, r = nwg % NXCD, xcd = wgid % NXCD, off = wgid / NXCD; wgid = (xcd < r ? xcd * (q + 1) : r * (q + 1) + (xcd - r) * q) + off; }
        const int nig = WGM * nN, gid = wgid / nig, fm = gid * WGM, gsz = (nM - fm) < WGM ? (nM - fm) : WGM;
        u.pm = fm + ((wgid % nig) % gsz); u.pn = (wgid % nig) / gsz; return true;
    }
    __device__ __forceinline__ void a_ready(const Unit&) const {}
    __device__ __forceinline__ void done(const Unit&) const {}
};

typedef unsigned u32x2 __attribute__((ext_vector_type(2)));
typedef float f32x2 __attribute__((ext_vector_type(2)));
typedef __bf16 bf16x2_t __attribute__((ext_vector_type(2)));
__device__ __forceinline__ unsigned cvt_pk_bf16(float lo, float hi) { f32x2 v = {lo, hi}; bf16x2_t b = __builtin_convertvector(v, bf16x2_t); return __builtin_bit_cast(unsigned, b); }
__device__ __forceinline__ u32x2 pack4(f32x4 v) { u32x2 w; w.x = cvt_pk_bf16(v[0], v[1]); w.y = cvt_pk_bf16(v[2], v[3]); return w; }
__device__ __forceinline__ void store8(bf16_t* p, u32x2 w) { *(u32x2*)p = w; }
__device__ __forceinline__ void store8_wt(bf16_t* p, u32x2 w) { __hip_atomic_store((unsigned long long*)p, (unsigned long long)w.x | ((unsigned long long)w.y << 32), __ATOMIC_RELAXED, __HIP_MEMORY_SCOPE_AGENT); }
__device__ __forceinline__ float dot4(f32x4 v) { return (v[0] * v[0] + v[1] * v[1]) + (v[2] * v[2] + v[3] * v[3]); }
__device__ __forceinline__ float red_fq(float s) { s += shx(s, 16); s += shx(s, 32); return s; }
constexpr float EPSN = 1e-6f;

struct EpiInProj {
    static constexpr bool PERM = false, AFTER_DRAIN = false, INIT = false;
    bf16_t *CQ, *CKV, *Kpe, *Qd, *Kd; float *ssq_q; const float *gk, *gdq, *gdk; const float* ropeA; const float* ropeB; float qscale_d; PG8_LAS float* part; unsigned* cntq; unsigned* cntkv;
    __device__ __forceinline__ void operator()(const f32x4 (&acc)[2][2][4][2], const Unit& u, int wr, int wc, int fr, int fq) const {
        asm volatile("" : "+v"(fr), "+v"(fq));
        const int pn = u.pn;
        if (pn == 2) {
#pragma unroll
            for (int ai = 0; ai < 2; ++ai)
#pragma unroll
                for (int m = 0; m < 4; ++m) {
                    float ss = 0.f;
#pragma unroll
                    for (int bj = 0; bj < 2; ++bj)
#pragma unroll
                        for (int n = 0; n < 2; ++n) ss += dot4(acc[ai][bj][m][n]);
                    ss = red_fq(ss);
                    if (fq == 0) part[(ai * HALF + wr * 64 + m * 16 + fr) * 4 + wc] = ss;
                }
            asm volatile("s_waitcnt lgkmcnt(0)" ::: "memory"); __builtin_amdgcn_s_barrier(); asm volatile("" ::: "memory");
#pragma unroll
            for (int ai = 0; ai < 2; ++ai)
#pragma unroll
                for (int m = 0; m < 4; ++m) {
                    const int rl = ai * HALF + wr * 64 + m * 16 + fr, row = u.pm * BM + rl;
                    const f32x4 q = *(const PG8_LAS f32x4*)(part + rl * 4);
                    const float rstd = rsqrtf(((q[0] + q[1]) + (q[2] + q[3])) * (1.f / 256.f) + EPSN);
                    bf16_t* dst = CKV + (size_t)row * 256 + 64 * wc;
#pragma unroll
                    for (int bj = 0; bj < 2; ++bj)
#pragma unroll
                        for (int n = 0; n < 2; ++n) store8_wt(dst + 32 * bj + 16 * n + 4 * fq, pack4(acc[ai][bj][m][n] * rstd));
                }
            asm volatile("s_waitcnt vmcnt(0)" ::: "memory");
            if (fr == 0 && fq == 0) __hip_atomic_fetch_add(cntkv + 64 * u.pm, 1u, __ATOMIC_RELAXED, __HIP_MEMORY_SCOPE_AGENT);
            return;
        }
#pragma unroll
        for (int ai = 0; ai < 2; ++ai)
#pragma unroll
            for (int m = 0; m < 4; ++m) {
                const int row = u.pm * BM + ai * HALF + wr * 64 + m * 16 + fr;
                if (pn < 2) {
                    if (pn != 1 || wc < 2) {
                        bf16_t* dst = CQ + (size_t)row * 384 + pn * 256 + 64 * wc;
                        float ss = 0.f;
#pragma unroll
                        for (int bj = 0; bj < 2; ++bj)
#pragma unroll
                            for (int n = 0; n < 2; ++n) { const f32x4 v = acc[ai][bj][m][n]; ss += dot4(v); store8_wt(dst + 32 * bj + 16 * n + 4 * fq, pack4(v)); }
                        ss = red_fq(ss);
                        if (fq == 0) __hip_atomic_store(ssq_q + (size_t)row * 8 + pn * 4 + wc, ss, __ATOMIC_RELAXED, __HIP_MEMORY_SCOPE_AGENT);
                    } else if (wc == 2) {
                        const f32x4 v0 = acc[ai][0][m][0], v1 = acc[ai][0][m][1];
                        float ss = red_fq(dot4(v0) + dot4(v1));
                        const float rstd = rsqrtf(ss * (1.f / 32.f) + EPSN);
                        const int s = row & (SEQ - 1);
                        const f32x4 g0 = *(const f32x4*)(gk + 64 + 4 * fq), g1 = *(const f32x4*)(gk + 80 + 4 * fq);
                        const f32x4 r0 = *(const f32x4*)(ropeA + (size_t)(s * 16 + 4 * fq) * 2), r1 = *(const f32x4*)(ropeA + (size_t)(s * 16 + 4 * fq) * 2 + 4);
                        const float cs[4] = {r0[0], r0[2], r1[0], r1[2]}, sn[4] = {r0[1], r0[3], r1[1], r1[3]};
                        f32x4 o1, o2;
#pragma unroll
                        for (int j = 0; j < 4; ++j) { const float x1 = v0[j] * rstd * g0[j], x2 = v1[j] * rstd * g1[j]; o1[j] = x1 * cs[j] - x2 * sn[j]; o2[j] = x2 * cs[j] + x1 * sn[j]; }
                        const u32x2 w1 = pack4(o1), w2 = pack4(o2);
                        store8(Kpe + (size_t)row * 32 + 4 * fq, w1); store8(Kpe + (size_t)row * 32 + 16 + 4 * fq, w2);
                    }
                } else {
                    const bool isq = pn < 5;
                    const int G8 = ((pn - 3) & 1) * 4 + wc;
                    const float* g = isq ? gdq : gdk;
                    bf16_t* dst = (isq ? Qd : Kd) + (size_t)row * 512 + G8 * 64;
                    float ss = 0.f;
#pragma unroll
                    for (int bj = 0; bj < 2; ++bj)
#pragma unroll
                        for (int n = 0; n < 2; ++n) ss += dot4(acc[ai][bj][m][n]);
                    ss = red_fq(ss);
                    const float rstd = rsqrtf(ss * (1.f / 64.f) + EPSN) * (isq ? qscale_d : 1.f);
                    const int s = row & (SEQ - 1);
#pragma unroll
                    for (int n = 0; n < 2; ++n) {
                        const int i0 = 16 * n + 4 * fq;
                        const f32x4 g0 = *(const f32x4*)(g + i0), g1 = *(const f32x4*)(g + 32 + i0);
                        const f32x4 r0 = *(const f32x4*)(ropeB + (size_t)(s * 32 + i0) * 2), r1 = *(const f32x4*)(ropeB + (size_t)(s * 32 + i0) * 2 + 4);
                        const float cs[4] = {r0[0], r0[2], r1[0], r1[2]}, sn[4] = {r0[1], r0[3], r1[1], r1[3]};
                        const f32x4 v0 = acc[ai][0][m][n], v1 = acc[ai][1][m][n];
                        f32x4 o1, o2;
#pragma unroll
                        for (int j = 0; j < 4; ++j) { const float x1 = v0[j] * rstd * g0[j], x2 = v1[j] * rstd * g1[j]; o1[j] = x1 * cs[j] - x2 * sn[j]; o2[j] = x2 * cs[j] + x1 * sn[j]; }
                        store8(dst + i0, pack4(o1)); store8(dst + 32 + i0, pack4(o2));
                    }
                }
            }
        if (pn < 2) {
            asm volatile("s_waitcnt vmcnt(0)" ::: "memory");
            if (fr == 0 && fq == 0) __hip_atomic_fetch_add(cntq + 64 * u.pm, 1u, __ATOMIC_RELAXED, __HIP_MEMORY_SCOPE_AGENT);
        }
    }
};

struct EpiStoreT {
    static constexpr bool PERM = false, AFTER_DRAIN = false, INIT = false;
    bf16_t* O; int ldo;
    __device__ __forceinline__ void operator()(const f32x4 (&acc)[2][2][4][2], const Unit& u, int wr, int wc, int fr, int fq) const {
        asm volatile("" : "+v"(fr), "+v"(fq));
        const int tok0 = u.pn * BM + wc * 32 + 4 * fq;
#pragma unroll
        for (int ai = 0; ai < 2; ++ai)
#pragma unroll
            for (int m = 0; m < 4; ++m) {
                const int row = u.pm * BM + ai * HALF + wr * 64 + m * 16 + fr;
                bf16_t* rp = O + (size_t)row * ldo + tok0;
#pragma unroll
                for (int bj = 0; bj < 2; ++bj)
#pragma unroll
                    for (int n = 0; n < 2; ++n) store8(rp + bj * HALF + n * 16, pack4(acc[ai][bj][m][n]));
            }
    }
};

struct EpiQUp {
    static constexpr bool PERM = false, AFTER_DRAIN = false, INIT = false;
    bf16_t* Qa; const float* ssq_q; const float* gq; const float* ropeA; float qscale;
    __device__ __forceinline__ void operator()(const f32x4 (&acc)[2][2][4][2], const Unit& u, int wr, int wc, int fr, int fq) const {
        asm volatile("" : "+v"(fr), "+v"(fq));
        const int ws = 4 * u.pn + wc;
#pragma unroll
        for (int ai = 0; ai < 2; ++ai)
#pragma unroll
            for (int m = 0; m < 4; ++m) {
                const int row = u.pm * BM + ai * HALF + wr * 64 + m * 16 + fr;
                float sq = 0.f; if (fq < 3) { const f32x2 qa = *(const f32x2*)(ssq_q + (size_t)row * 8 + 2 * fq); sq = qa[0] + qa[1]; }
                const float rstd_a = rsqrtf(red_fq(sq) * (1.f / 384.f) + EPSN);
                if (ws < 8) {
                    float ss = 0.f;
#pragma unroll
                    for (int bj = 0; bj < 2; ++bj)
#pragma unroll
                        for (int n = 0; n < 2; ++n) ss += dot4(acc[ai][bj][m][n] * rstd_a);
                    ss = red_fq(ss);
                    const float r2 = rsqrtf(ss * (1.f / 64.f) + EPSN) * qscale * rstd_a;
                    bf16_t* dst = Qa + (size_t)row * 768 + ws * 96;
#pragma unroll
                    for (int bj = 0; bj < 2; ++bj)
#pragma unroll
                        for (int n = 0; n < 2; ++n) { const int d0 = 32 * bj + 16 * n + 4 * fq; const f32x4 g = *(const f32x4*)(gq + d0); store8(dst + d0, pack4(acc[ai][bj][m][n] * g * r2)); }
                } else {
                    const int s = row & (SEQ - 1);
                    const f32x4 g0 = *(const f32x4*)(gq + 64 + 4 * fq), g1 = *(const f32x4*)(gq + 80 + 4 * fq);
                    const f32x4 r0 = *(const f32x4*)(ropeA + (size_t)(s * 16 + 4 * fq) * 2), r1 = *(const f32x4*)(ropeA + (size_t)(s * 16 + 4 * fq) * 2 + 4);
                    const float cs[4] = {r0[0], r0[2], r1[0], r1[2]}, sn[4] = {r0[1], r0[3], r1[1], r1[3]};
#pragma unroll
                    for (int bj = 0; bj < 2; ++bj) {
                        const int h = 2 * (ws - 8) + bj;
                        const f32x4 v0 = acc[ai][bj][m][0] * rstd_a, v1 = acc[ai][bj][m][1] * rstd_a;
                        const float ss = red_fq(dot4(v0) + dot4(v1));
                        const float r2 = rsqrtf(ss * (1.f / 32.f) + EPSN);
                        f32x4 o1, o2;
#pragma unroll
                        for (int j = 0; j < 4; ++j) { const float x1 = v0[j] * r2 * g0[j], x2 = v1[j] * r2 * g1[j]; o1[j] = (x1 * cs[j] - x2 * sn[j]) * qscale; o2[j] = (x2 * cs[j] + x1 * sn[j]) * qscale; }
                        bf16_t* dst = Qa + (size_t)row * 768 + h * 96 + 64 + 4 * fq;
                        store8(dst, pack4(o1)); store8(dst + 16, pack4(o2));
                    }
                }
                asm volatile("" ::: "memory");
            }
    }
};

struct EpiKUp {
    static constexpr bool PERM = false, AFTER_DRAIN = false, INIT = false;
    bf16_t* Ka; const float* gk;
    __device__ __forceinline__ void operator()(const f32x4 (&acc)[2][2][4][2], const Unit& u, int wr, int wc, int fr, int fq) const {
        asm volatile("" : "+v"(fr), "+v"(fq));
        const int h = 4 * u.pn + wc;
#pragma unroll
        for (int ai = 0; ai < 2; ++ai)
#pragma unroll
            for (int m = 0; m < 4; ++m) {
                const int row = u.pm * BM + ai * HALF + wr * 64 + m * 16 + fr;
                float ss = 0.f;
#pragma unroll
                for (int bj = 0; bj < 2; ++bj)
#pragma unroll
                    for (int n = 0; n < 2; ++n) ss += dot4(acc[ai][bj][m][n]);
                ss = red_fq(ss);
                const float r2 = rsqrtf(ss * (1.f / 64.f) + EPSN);
                bf16_t* dst = Ka + (size_t)row * 512 + h * 64;
#pragma unroll
                for (int bj = 0; bj < 2; ++bj)
#pragma unroll
                    for (int n = 0; n < 2; ++n) { const int d0 = 32 * bj + 16 * n + 4 * fq; const f32x4 g = *(const f32x4*)(gk + d0); store8(dst + d0, pack4(acc[ai][bj][m][n] * g * r2)); }
            }
    }
};

struct EpiWOut {
    static constexpr bool PERM = false, AFTER_DRAIN = false, INIT = true;
    const float* x; float* out; bf16_t* X1b; float* ssq_x1; f32x4 (&pre)[2][2][4][2]; bool use_pre;
    __device__ __forceinline__ void init_next(f32x4 (&acc)[2][2][4][2], const Unit& u, int wr, int wc, int fr, int fq) const {
        const int col0 = u.pn * BM + wc * 32 + 4 * fq;
#pragma unroll
        for (int ai = 0; ai < 2; ++ai)
#pragma unroll
            for (int m = 0; m < 4; ++m) {
                const size_t off = (size_t)(u.pm * BM + ai * HALF + wr * 64 + m * 16 + fr) * DM + col0;
#pragma unroll
                for (int bj = 0; bj < 2; ++bj)
#pragma unroll
                    for (int n = 0; n < 2; ++n) acc[ai][bj][m][n] = *(const f32x4*)(x + off + bj * HALF + n * 16);
            }
    }
    __device__ __forceinline__ void init(f32x4 (&acc)[2][2][4][2], const Unit& u, int wr, int wc, int fr, int fq) const {
        if (use_pre) {
#pragma unroll
            for (int a = 0; a < 2; ++a)
#pragma unroll
                for (int bb = 0; bb < 2; ++bb)
#pragma unroll
                    for (int m = 0; m < 4; ++m)
#pragma unroll
                        for (int n = 0; n < 2; ++n) acc[a][bb][m][n] = pre[a][bb][m][n];
            return;
        }
        const int col0 = u.pn * BM + wc * 32 + 4 * fq;
#pragma unroll
        for (int ai = 0; ai < 2; ++ai)
#pragma unroll
            for (int m = 0; m < 4; ++m) {
                const size_t off = (size_t)(u.pm * BM + ai * HALF + wr * 64 + m * 16 + fr) * DM + col0;
#pragma unroll
                for (int bj = 0; bj < 2; ++bj)
#pragma unroll
                    for (int n = 0; n < 2; ++n) acc[ai][bj][m][n] = *(const f32x4*)(x + off + bj * HALF + n * 16);
            }
    }
    __device__ __forceinline__ void operator()(const f32x4 (&acc)[2][2][4][2], const Unit& u, int wr, int wc, int fr, int fq) const {
        asm volatile("" : "+v"(fr), "+v"(fq));
        const int col0 = u.pn * BM + wc * 32 + 4 * fq;
#pragma unroll
        for (int ai = 0; ai < 2; ++ai)
#pragma unroll
            for (int m = 0; m < 4; ++m) {
                const int row = u.pm * BM + ai * HALF + wr * 64 + m * 16 + fr;
                const size_t off = (size_t)row * DM + col0;
                float ss = 0.f;
#pragma unroll
                for (int bj = 0; bj < 2; ++bj)
#pragma unroll
                    for (int n = 0; n < 2; ++n) {
                        const size_t o = off + bj * HALF + n * 16;
                        const f32x4 v = acc[ai][bj][m][n];
                        store8(X1b + o, pack4(v)); ss += dot4(v);
                    }
                ss = red_fq(ss);
                if (fq == 0) ssq_x1[(size_t)row * 16 + u.pn * 4 + wc] = ss;
            }
    }
};

struct EpiGateUp {
    static constexpr bool PERM = false, AFTER_DRAIN = false, INIT = false;
    bf16_t* A; float* HL; const float* ssq_x1; const float* conv_w; const float* conv_b;
    __device__ __forceinline__ void operator()(f32x4 (&acc)[2][2][4][2], const Unit& u, int wr, int wc, int fr, int fq) const {
        asm volatile("" : "+v"(fr), "+v"(fq));
        const int lane = fq * 16 + fr;
#pragma unroll
        for (int ai = 0; ai < 2; ++ai)
#pragma unroll
            for (int m = 0; m < 4; ++m) {
                const int row = u.pm * BM + ai * HALF + wr * 64 + m * 16 + fr;
                const f32x4 a = *(const f32x4*)(ssq_x1 + (size_t)row * 16 + 4 * fq);
                const float rs = rsqrtf(red_fq((a[0] + a[1]) + (a[2] + a[3])) * (1.f / 1024.f) + EPSN);
#pragma unroll
                for (int bj = 0; bj < 2; ++bj)
#pragma unroll
                    for (int n = 0; n < 2; ++n) acc[ai][bj][m][n] *= rs;
            }
#pragma unroll
        for (int n = 0; n < 2; ++n) {
            const int f = u.pn * 128 + wc * 32 + 16 * n + 4 * fq;
            const f32x4 w0 = *(const f32x4*)(conv_w + f), w1 = *(const f32x4*)(conv_w + FF + f), w2 = *(const f32x4*)(conv_w + 2 * FF + f), cb = *(const f32x4*)(conv_b + f);
#pragma unroll
            for (int ai = 0; ai < 2; ++ai) {
                f32x4 gprev = (f32x4){0.f, 0.f, 0.f, 0.f};
                const int kb = u.pm * 4 + ai * 2 + wr;
#pragma unroll
                for (int m = 0; m < 4; ++m) {
                    const int row = u.pm * BM + ai * HALF + wr * 64 + m * 16 + fr;
                    const f32x4 gc = acc[ai][0][m][n], uc = acc[ai][1][m][n];
                    f32x4 o;
#pragma unroll
                    for (int j = 0; j < 4; ++j) {
                        const float y1 = (fr == 15) ? gprev[j] : gc[j], y2 = (fr >= 14) ? gprev[j] : gc[j];
                        const float g1 = __builtin_bit_cast(float, __builtin_amdgcn_update_dpp(0, __builtin_bit_cast(int, y1), 0x121, 0xF, 0xF, false));
                        const float g2 = __builtin_bit_cast(float, __builtin_amdgcn_update_dpp(0, __builtin_bit_cast(int, y2), 0x122, 0xF, 0xF, false));
                        const float cv = w2[j] * gc[j] + w1[j] * g1 + w0[j] * g2 + cb[j];
                        o[j] = cv * __builtin_amdgcn_rcpf(1.f + __expf(-cv)) * uc[j];
                    }
                    if (m != 0 || fr >= 2) store8(A + (size_t)row * FF + f, pack4(o));
                    if (m == 0 && fr < 2) { *(f32x4*)(HL + ((size_t)kb * 6 + 2 + fr) * FF + f) = gc; *(f32x4*)(HL + ((size_t)kb * 6 + 4 + fr) * FF + f) = uc; }
                    if (m == 3 && fr >= 14) *(f32x4*)(HL + ((size_t)kb * 6 + (fr - 14)) * FF + f) = gc;
                    gprev = gc;
                }
            }
        }
    }
};

struct EpiDown {
    static constexpr bool PERM = false, AFTER_DRAIN = false, INIT = true;
    const bf16_t* src; float* out; u32x2 (&pre)[2][2][4][2]; bool use_pre;
    __device__ __forceinline__ void init_next(f32x4 (&acc)[2][2][4][2], const Unit& u, int wr, int wc, int fr, int fq) const { load_tile(acc, u, wr, wc, fr, fq); }
    __device__ __forceinline__ void init(f32x4 (&acc)[2][2][4][2], const Unit& u, int wr, int wc, int fr, int fq) const {
        if (use_pre) {
#pragma unroll
            for (int a = 0; a < 2; ++a)
#pragma unroll
                for (int bb = 0; bb < 2; ++bb)
#pragma unroll
                    for (int m = 0; m < 4; ++m)
#pragma unroll
                        for (int n = 0; n < 2; ++n) { const u32x2 w = pre[a][bb][m][n]; acc[a][bb][m][n] = (f32x4){__builtin_bit_cast(float, w.x << 16), __builtin_bit_cast(float, w.x & 0xffff0000u), __builtin_bit_cast(float, w.y << 16), __builtin_bit_cast(float, w.y & 0xffff0000u)}; }
            return;
        }
        load_tile(acc, u, wr, wc, fr, fq);
    }
    __device__ __forceinline__ void load_tile(f32x4 (&acc)[2][2][4][2], const Unit& u, int wr, int wc, int fr, int fq) const {
        const int col0 = u.pn * BM + wc * 32 + 4 * fq;
#pragma unroll
        for (int ai = 0; ai < 2; ++ai)
#pragma unroll
            for (int m = 0; m < 4; ++m) {
                const size_t off = (size_t)(u.pm * BM + ai * HALF + wr * 64 + m * 16 + fr) * DM + col0;
#pragma unroll
                for (int bj = 0; bj < 2; ++bj)
#pragma unroll
                    for (int n = 0; n < 2; ++n) { const u32x2 w = *(const u32x2*)(src + off + bj * HALF + n * 16); acc[ai][bj][m][n] = (f32x4){__builtin_bit_cast(float, w.x << 16), __builtin_bit_cast(float, w.x & 0xffff0000u), __builtin_bit_cast(float, w.y << 16), __builtin_bit_cast(float, w.y & 0xffff0000u)}; }
            }
    }
    __device__ __forceinline__ void operator()(const f32x4 (&acc)[2][2][4][2], const Unit& u, int wr, int wc, int fr, int fq) const {
        asm volatile("" : "+v"(fr), "+v"(fq));
        const int col0 = u.pn * BM + wc * 32 + 4 * fq;
#pragma unroll
        for (int ai = 0; ai < 2; ++ai)
#pragma unroll
            for (int m = 0; m < 4; ++m) {
                const size_t off = (size_t)(u.pm * BM + ai * HALF + wr * 64 + m * 16 + fr) * DM + col0;
#pragma unroll
                for (int bj = 0; bj < 2; ++bj)
#pragma unroll
                    for (int n = 0; n < 2; ++n) *(f32x4*)(out + off + bj * HALF + n * 16) = acc[ai][bj][m][n];
            }
    }
};

template <class Epi, class Sched, bool ALIGN_EPI = false, bool SP2 = false>
__device__ __forceinline__ void gemm_phase(PG8_LAS unsigned char* lds, const Gemm g, const Sched& S, const Epi& E, const int wave_s) {
    int tid_ = wave_s * 64 + lane_fresh(); asm volatile("" : "+v"(tid_));
    const int tid = tid_, wid = __builtin_amdgcn_readfirstlane(tid >> 6), lane = tid & 63, wr = wid >> 2, wc = wid & 3, fr = lane & 15, fq = lane >> 4;
    const int K = g.K, nt = K / BK;
    unsigned voffA[2], voffB[2];
#pragma unroll
    for (int i = 0; i < 2; ++i) { int R, C; stage_rc(tid * 16 + i * 8192, R, C); const int Rb = Epi::PERM ? ((R & ~31) + perm32(R & 31)) : R;
        voffA[i] = (unsigned)(R * K + C) * 2u; voffB[i] = (unsigned)(Rb * K + C) * 2u; }
    const size_t kstep = (size_t)(BK * 2);
    const size_t hstep = (size_t)HALF * K * 2;
    const size_t tstep = 2 * hstep;
    const unsigned ldsw = (unsigned)wid * 1024u;
    const int aoff = lds_byte(wr * 64 + fr, fq * 8), boff = lds_byte(wc * 32 + fr, fq * 8);
#define PG8_SA(b, h) (((b) * 2 + (h)) * HTB)
#define PG8_SB(b, h) ((4 + (b) * 2 + (h)) * HTB)
#define PG8_STAGE(bufoff, gbase, voff) do { _Pragma("unroll") for (int _i = 0; _i < 2; ++_i) \
        __builtin_amdgcn_global_load_lds((const unsigned*)((const char*)(gbase) + (voff)[_i]), (PG8_LAS unsigned*)(lds + (bufoff) + ldsw + _i * 8192), 16, 0, 0); } while (0)
#define PG8_LDA(dst, b, h) do { _Pragma("unroll") for (int m = 0; m < 4; ++m) _Pragma("unroll") for (int k = 0; k < 2; ++k) dst[m][k] = *(const PG8_LAS bf16x8*)(lds + PG8_SA(b, h) + aoff + m * 2048 + k * 1024); } while (0)
#define PG8_LDB(dst, b, h) do { _Pragma("unroll") for (int n = 0; n < 2; ++n) _Pragma("unroll") for (int k = 0; k < 2; ++k) dst[n][k] = *(const PG8_LAS bf16x8*)(lds + PG8_SB(b, h) + boff + n * 2048 + k * 1024); } while (0)
#define PG8_MMA(ai, bj, At, Bt) do { __builtin_amdgcn_s_setprio(1); _Pragma("unroll") for (int m = 0; m < 4; ++m) _Pragma("unroll") for (int n = 0; n < 2; ++n) _Pragma("unroll") for (int k = 0; k < 2; ++k) \
        acc[ai][bj][m][n] = __builtin_amdgcn_mfma_f32_16x16x32_bf16(Bt[n][k], At[m][k], acc[ai][bj][m][n], 0, 0, 0); __builtin_amdgcn_s_setprio(0); } while (0)
#define PG8_WAIT_V(n) asm volatile("s_waitcnt vmcnt(" #n ")" ::: "memory")
#define PG8_WAIT_L(n) asm volatile("s_waitcnt lgkmcnt(" #n ")" ::: "memory")
#define PG8_BAR __builtin_amdgcn_s_barrier()
#define PG8_SCHED __builtin_amdgcn_sched_barrier(0)
    Unit cur, nxt; int ui = 0;
    if (!S.next(0, cur)) return;
    f32x4 acc[2][2][4][2];
#pragma unroll
    for (int a = 0; a < 2; ++a)
#pragma unroll
        for (int b = 0; b < 2; ++b)
#pragma unroll
            for (int m = 0; m < 4; ++m)
#pragma unroll
                for (int n = 0; n < 2; ++n) acc[a][b][m][n] = (f32x4){0.f, 0.f, 0.f, 0.f};
    if constexpr (Epi::INIT) E.init(acc, cur, wr, wc, fr, fq);
    bf16x8 At[4][2], B0[2][2], B1[2][2];
    const char* cA = (const char*)g.A + (size_t)cur.pm * tstep; const char* cB = (const char*)g.Bt + (size_t)cur.pn * tstep;
    S.a_ready(cur);
    if constexpr (SP2) {
        PG8_STAGE(PG8_SB(0, 0), cB, voffB); PG8_STAGE(PG8_SB(0, 1), cB + hstep, voffB); PG8_STAGE(PG8_SA(0, 0), cA, voffA); PG8_STAGE(PG8_SA(0, 1), cA + hstep, voffA);
        if (wr == 1) PG8_BAR;
        PG8_WAIT_V(2); PG8_BAR;
        PG8_STAGE(PG8_SB(1, 0), cB + kstep, voffB); PG8_STAGE(PG8_SA(1, 0), cA + kstep, voffA); PG8_STAGE(PG8_SB(1, 1), cB + hstep + kstep, voffB);
        PG8_WAIT_V(6); PG8_BAR;
    } else {
        PG8_STAGE(PG8_SB(0, 0), cB, voffB); PG8_STAGE(PG8_SA(0, 0), cA, voffA); PG8_STAGE(PG8_SB(0, 1), cB + hstep, voffB); PG8_STAGE(PG8_SA(0, 1), cA + hstep, voffA);
        if (wr == 1) PG8_BAR;
        PG8_WAIT_V(4); PG8_BAR;
        PG8_STAGE(PG8_SB(1, 0), cB + kstep, voffB); PG8_STAGE(PG8_SA(1, 0), cA + kstep, voffA); PG8_STAGE(PG8_SB(1, 1), cB + hstep + kstep, voffB);
        PG8_WAIT_V(6); PG8_BAR;
    }
    for (;;) {
        const bool has_next = S.next(ui + 1, nxt);
        const char* nA = has_next ? (const char*)g.A + (size_t)nxt.pm * tstep : cA; const char* nB = has_next ? (const char*)g.Bt + (size_t)nxt.pn * tstep : cB;
        for (int t = 0; t < nt; t += 2) {
            const bool last = (t == nt - 2);
            const char* a1 = cA + (size_t)(t + 1) * kstep;
            const char* a2 = last ? nA : cA + (size_t)(t + 2) * kstep; const char* b2 = last ? nB : cB + (size_t)(t + 2) * kstep;
            const char* a3 = a2 + kstep; const char* b3 = b2 + kstep;
            if (last && has_next) S.a_ready(nxt);
            if constexpr (SP2) {
            PG8_LDB(B0, 0, 0); PG8_LDB(B1, 0, 1); PG8_SCHED; PG8_LDA(At, 0, 0); PG8_STAGE(PG8_SA(1, 1), a1 + hstep, voffA);
            PG8_WAIT_V(8); PG8_WAIT_L(0); PG8_BAR; PG8_MMA(0, 0, At, B0); PG8_MMA(0, 1, At, B1); PG8_BAR; PG8_SCHED;
            PG8_LDA(At, 0, 1); PG8_STAGE(PG8_SB(0, 0), b2, voffB); PG8_STAGE(PG8_SB(0, 1), b2 + hstep, voffB); PG8_STAGE(PG8_SA(0, 0), a2, voffA);
            PG8_WAIT_V(8); PG8_WAIT_L(0); PG8_BAR; PG8_MMA(1, 0, At, B0); PG8_MMA(1, 1, At, B1); PG8_BAR; PG8_SCHED;
            PG8_LDB(B0, 1, 0); PG8_LDB(B1, 1, 1); PG8_SCHED; PG8_LDA(At, 1, 0); PG8_STAGE(PG8_SA(0, 1), a2 + hstep, voffA);
            PG8_WAIT_V(8); PG8_WAIT_L(0); PG8_BAR; PG8_MMA(0, 0, At, B0); PG8_MMA(0, 1, At, B1); PG8_BAR; PG8_SCHED;
            PG8_LDA(At, 1, 1); PG8_STAGE(PG8_SB(1, 0), b3, voffB); PG8_STAGE(PG8_SB(1, 1), b3 + hstep, voffB); PG8_STAGE(PG8_SA(1, 0), a3, voffA);
            PG8_WAIT_V(8); PG8_WAIT_L(0); PG8_BAR; PG8_MMA(1, 0, At, B0); PG8_MMA(1, 1, At, B1); PG8_BAR; PG8_SCHED;
            } else {
            PG8_LDB(B0, 0, 0); PG8_SCHED; PG8_LDA(At, 0, 0); PG8_STAGE(PG8_SA(1, 1), a1 + hstep, voffA);
            PG8_WAIT_L(8); PG8_BAR; PG8_WAIT_L(0); PG8_MMA(0, 0, At, B0); PG8_BAR; PG8_SCHED;
            PG8_LDB(B1, 0, 1); PG8_STAGE(PG8_SB(0, 0), b2, voffB);
            PG8_BAR; PG8_WAIT_L(0); PG8_MMA(0, 1, At, B1); PG8_BAR;
            PG8_LDA(At, 0, 1); PG8_STAGE(PG8_SA(0, 0), a2, voffA);
            PG8_BAR; PG8_WAIT_L(0); PG8_MMA(1, 0, At, B0); PG8_BAR; PG8_SCHED;
            PG8_STAGE(PG8_SB(0, 1), b2 + hstep, voffB);
            PG8_WAIT_V(6); PG8_BAR; PG8_MMA(1, 1, At, B1); PG8_BAR;
            PG8_LDB(B0, 1, 0); PG8_SCHED; PG8_LDA(At, 1, 0); PG8_STAGE(PG8_SA(0, 1), a2 + hstep, voffA);
            PG8_WAIT_L(8); PG8_BAR; PG8_WAIT_L(0); PG8_MMA(0, 0, At, B0); PG8_BAR; PG8_SCHED;
            PG8_LDB(B1, 1, 1); PG8_STAGE(PG8_SB(1, 0), b3, voffB);
            PG8_BAR; PG8_WAIT_L(0); PG8_MMA(0, 1, At, B1); PG8_BAR;
            PG8_LDA(At, 1, 1); PG8_STAGE(PG8_SA(1, 0), a3, voffA);
            PG8_BAR; PG8_WAIT_L(0); PG8_MMA(1, 0, At, B0); PG8_BAR; PG8_SCHED;
            PG8_STAGE(PG8_SB(1, 1), b3 + hstep, voffB);
            PG8_WAIT_V(6); PG8_BAR; PG8_MMA(1, 1, At, B1); PG8_BAR;
            }
        }
        if constexpr (ALIGN_EPI) { if (wr == 0) PG8_BAR; }
        if constexpr (!Epi::AFTER_DRAIN) { E(acc, cur, wr, wc, fr, fq); S.done(cur); }
        if (!has_next) break;
#pragma unroll
        for (int a = 0; a < 2; ++a)
#pragma unroll
            for (int b = 0; b < 2; ++b)
#pragma unroll
                for (int m = 0; m < 4; ++m)
#pragma unroll
                    for (int n = 0; n < 2; ++n) acc[a][b][m][n] = (f32x4){0.f, 0.f, 0.f, 0.f};
        if constexpr (Epi::INIT) E.init_next(acc, nxt, wr, wc, fr, fq);
        cur = nxt; cA = nA; cB = nB; ++ui;
        if constexpr (ALIGN_EPI) { if (wr == 1) PG8_BAR; }
    }
    PG8_WAIT_V(0);
    if constexpr (!ALIGN_EPI) { if (wr == 0) PG8_BAR; }
    PG8_BAR;
    if constexpr (Epi::AFTER_DRAIN) { E.fused(acc, cur, wr, wc, fr, fq, lds, wid, lane); S.done(cur); }
#undef PG8_SA
#undef PG8_SB
#undef PG8_STAGE
#undef PG8_LDA
#undef PG8_LDB
#undef PG8_MMA
#undef PG8_WAIT_V
#undef PG8_WAIT_L
#undef PG8_BAR
#undef PG8_SCHED
}
}

#define LAS __attribute__((address_space(3)))
using pg8::bf16_t; using pg8::bf16x8; using pg8::f32x4; using pg8::u32x4; using pg8::u32x2;
typedef float f32x16 __attribute__((ext_vector_type(16)));
constexpr int NWAVES = 8, NTHR = 512;
constexpr int LDS_BYTES = 147456;

constexpr size_t MiB = 1u << 20;
constexpr size_t WS_ROPEA = 0, WS_ROPEB = 262144, WS_CTL = 800 * 1024, CTL_BYTES = 65536;
constexpr size_t WS_WIN = 1 * MiB;
constexpr size_t WS_WDV = WS_WIN + (size_t)1792 * 1024 * 2;
constexpr size_t WS_WQ = WS_WDV + (size_t)512 * 1024 * 2;
constexpr size_t WS_WK = WS_WQ + (size_t)768 * 384 * 2;
constexpr size_t WS_WV = WS_WK + (size_t)512 * 256 * 2;
constexpr size_t WS_WO = WS_WV + (size_t)512 * 256 * 2;
constexpr size_t WS_WGU = WS_WO + (size_t)1024 * 1024 * 2;
constexpr size_t WS_WD = WS_WGU + (size_t)5632 * 1024 * 2;
static_assert(WS_WD + (size_t)1024 * 2816 * 2 <= 26 * MiB, "weights");
constexpr size_t WS_SSQQ = 26 * MiB, WS_SSQKV = 26 * MiB + 524288, WS_SSQX = 27 * MiB;
constexpr size_t WS_H = 28 * MiB;
constexpr size_t WS_CQ = 60 * MiB, WS_CKV = 72 * MiB, WS_QA = 80 * MiB, WS_KA = 104 * MiB, WS_VTA = 128 * MiB;
constexpr size_t WS_ABUF = 60 * MiB;
constexpr size_t WS_QD = 148 * MiB, WS_KD = 164 * MiB, WS_VTD = 180 * MiB, WS_O = 196 * MiB, WS_HL = 228 * MiB;
static_assert(WS_ABUF + (size_t)M * FF * 2 <= WS_QD && WS_HL + (size_t)256 * 6 * FF * 4 <= 256 * MiB, "d_ws map");

struct Params {
    const float* in[23]; float* out; unsigned char* ws;
    float invA[16]; float invB[32];
    int ph_lo, ph_hi;
};

__device__ __forceinline__ float wave_sum(float v) {
#pragma unroll
    for (int o = 1; o < 64; o <<= 1) v += shx(v, o);
    return v;
}
__device__ __forceinline__ unsigned pk2(float lo, float hi) { return pg8::cvt_pk_bf16(lo, hi); }

__device__ __forceinline__ void p0_transpose_item(const float* W, int ldw, int K, bf16_t* WT, int drow0, const float* gain, LAS float* scr, int k0, int n0, int lane) {
    {
        const int kr = lane >> 3, nc = (lane & 7) * 4;
        const float* wp = W + (size_t)(k0 + kr) * ldw + n0 + nc;
        f32x4 wv[8];
#pragma unroll
        for (int i = 0; i < 8; ++i) wv[i] = *(const f32x4*)(wp + (size_t)(8 * i) * ldw);
        if (gain) {
#pragma unroll
            for (int i = 0; i < 8; ++i) wv[i] *= gain[k0 + 8 * i + kr];
        }
#pragma unroll
        for (int i = 0; i < 8; ++i) { LAS float* d = scr + (8 * i + kr) * 33 + nc; d[0] = wv[i][0]; d[1] = wv[i][1]; d[2] = wv[i][2]; d[3] = wv[i][3]; }
    }
    asm volatile("s_waitcnt lgkmcnt(0)" ::: "memory");
    const int c = lane & 7;
#pragma unroll
    for (int j = 0; j < 4; ++j) { const int n = (lane >> 3) + 8 * j; const LAS float* s = scr + (8 * c) * 33 + n;
        u32x4 o; o.x = pk2(s[0 * 33], s[1 * 33]); o.y = pk2(s[2 * 33], s[3 * 33]); o.z = pk2(s[4 * 33], s[5 * 33]); o.w = pk2(s[6 * 33], s[7 * 33]);
        *(u32x4*)(WT + (size_t)(drow0 + n) * K + k0 + 8 * c) = o; }
    asm volatile("s_waitcnt lgkmcnt(0)" ::: "memory");
}

__device__ __forceinline__ void convert_items(const Params& p, LAS unsigned char* lds, int it0, int it1, int gw, int NGW, int wave, int lane) {
    unsigned char* ws = p.ws;
    LAS float* scr = (LAS float*)(lds + wave * 16384);
    bf16_t* Win = (bf16_t*)(ws + WS_WIN); bf16_t* Wdv = (bf16_t*)(ws + WS_WDV); bf16_t* Wq = (bf16_t*)(ws + WS_WQ); bf16_t* Wk = (bf16_t*)(ws + WS_WK);
    bf16_t* Wv = (bf16_t*)(ws + WS_WV); bf16_t* Wo = (bf16_t*)(ws + WS_WO); bf16_t* Wgu = (bf16_t*)(ws + WS_WGU); bf16_t* Wd = (bf16_t*)(ws + WS_WD);
    constexpr int I_IN = 16 * 69, I_Q = 6 * 24, I_KV = 4 * 32, I_O = 16 * 32, I_G = 16 * 88, I_D = 44 * 32;
    constexpr int NITEMS = I_IN + I_Q + I_KV + I_O + 2 * I_G + I_D;
    for (int it = it0 + gw; it < it1; it += NGW) {
        int r = it;
        if (r < I_IN) { const int kb = r / 69, nb = r % 69, n0 = nb * 32;
            if (n0 < 1696) { const int L = (n0 < 384) ? n0 : (n0 < 640) ? 512 + (n0 - 384) : (n0 < 672) ? 384 + (n0 - 640) : (n0 < 1184) ? 768 + (n0 - 672) : 1280 + (n0 - 1184);
                const int T = L >> 8, l = L & 255, g = l >> 6, bj = (l >> 5) & 1;
                p0_transpose_item(p.in[2], 2208, 1024, Win, 256 * T + 128 * bj + 32 * g, nullptr, scr, kb * 64, n0, lane); }
            else p0_transpose_item(p.in[2], 2208, 1024, Wdv, n0 - 1696, nullptr, scr, kb * 64, n0, lane);
            continue; }
        r -= I_IN;
        if (r < I_Q) { const int kb = r / 24, nb = r % 24, n0 = nb * 32, h = n0 / 96, blk = (n0 % 96) / 32;
            const int wsl = (blk < 2) ? h : 8 + (h >> 1), bj = (blk < 2) ? blk : (h & 1);
            p0_transpose_item(p.in[4], 768, 384, Wq, 256 * (wsl >> 2) + 128 * bj + 32 * (wsl & 3), p.in[3], scr, kb * 64, n0, lane); continue; }
        r -= I_Q;
        if (r < I_KV) { const int kb = r / 32, nb = r % 32, n0 = nb * 32, h = n0 >> 7, c0 = n0 & 127;
            if (c0 < 64) p0_transpose_item(p.in[6], 1024, 256, Wk, 256 * (h >> 2) + 128 * (c0 >> 5) + 32 * (h & 3), p.in[5], scr, kb * 64, n0, lane);
            else p0_transpose_item(p.in[6], 1024, 256, Wv, h * 64 + (c0 - 64), p.in[5], scr, kb * 64, n0, lane);
            continue; }
        r -= I_KV;
        if (r < I_O) { const int kb = r / 32, nb = r % 32; p0_transpose_item(p.in[16], 1024, 1024, Wo, nb * 32, nullptr, scr, kb * 64, nb * 32, lane); continue; }
        r -= I_O;
        if (r < 2 * I_G) { const int up = r >= I_G; if (up) r -= I_G; const int kb = r / 88, nb = r % 88, f0 = nb * 32;
            p0_transpose_item(p.in[up ? 19 : 18], FF, 1024, Wgu, 256 * (f0 >> 7) + 128 * up + 32 * ((f0 >> 5) & 3), p.in[17], scr, kb * 64, f0, lane); continue; }
        r -= 2 * I_G;
        { const int kb = r / 32, nb = r % 32; p0_transpose_item(p.in[22], 1024, FF, Wd, nb * 32, nullptr, scr, kb * 64, nb * 32, lane); }
    }
}
constexpr int CONV_EARLY = 16 * 69 + 6 * 24 + 4 * 32, CONV_ALL = CONV_EARLY + 16 * 32 + 2 * 16 * 88 + 44 * 32;
__device__ __forceinline__ void p0_prologue(const Params& p, LAS unsigned char* lds, int vcu, int G, int wave, int lane) {
    unsigned char* ws = p.ws;
    const int gw = vcu * NWAVES + wave, NGW = G * NWAVES;
    bf16_t* Win = (bf16_t*)(ws + WS_WIN);
    for (int i = gw * 64 + lane; i < 96 * 128; i += NGW * 64) { const int rr = i >> 7, c = i & 127; const int row = 256 + (rr < 32 ? 352 - 256 + rr : 448 - 256 + (rr - 32)); *(u32x4*)(Win + (size_t)row * 1024 + c * 8) = (u32x4){0u, 0u, 0u, 0u}; }
    float* ropeA = (float*)(ws + WS_ROPEA); float* ropeB = (float*)(ws + WS_ROPEB);
    for (int i = gw * 64 + lane; i < SEQ * 48; i += NGW * 64) {
        const bool isA = i < SEQ * 16; const int e = isA ? i : i - SEQ * 16; const int s = isA ? e >> 4 : e >> 5, k = isA ? e & 15 : e & 31;
        const float ang = (float)s * (isA ? p.invA[k] : p.invB[k]);
        const double rev = (double)ang * 0.15915494309189535; const float fr = (float)(rev - floor(rev));
        const float sn = __builtin_amdgcn_sinf(fr), cs = __builtin_amdgcn_cosf(fr);
        float* dst = (isA ? ropeA : ropeB) + (size_t)e * 2; dst[0] = cs; dst[1] = sn;
    }
    bf16_t* H = (bf16_t*)(ws + WS_H); const float* x = p.in[0]; const float* g = p.in[1];
    f32x4 gv[4];
#pragma unroll
    for (int j = 0; j < 4; ++j) gv[j] = *(const f32x4*)(g + 4 * lane + 256 * j);
    for (int m0 = gw; m0 < M; m0 += 4 * NGW) {
        f32x4 v[4][4]; float s[4];
#pragma unroll
        for (int q = 0; q < 4; ++q) { const int m = m0 + q * NGW; const f32x4* xr = (const f32x4*)(x + (size_t)(m < M ? m : m0) * DM) + lane;
#pragma unroll
            for (int j = 0; j < 4; ++j) v[q][j] = __builtin_nontemporal_load(xr + 64 * j); }
#pragma unroll
        for (int q = 0; q < 4; ++q) { s[q] = 0.f;
#pragma unroll
            for (int j = 0; j < 4; ++j) s[q] += pg8::dot4(v[q][j]); }
#pragma unroll
        for (int o = 1; o < 64; o <<= 1) { const int idx = (lane_fresh() ^ o) << 2;
#pragma unroll
            for (int q = 0; q < 4; ++q) s[q] += __builtin_bit_cast(float, __builtin_amdgcn_ds_bpermute(idx, __builtin_bit_cast(int, s[q]))); }
#pragma unroll
        for (int q = 0; q < 4; ++q) { const int m = m0 + q * NGW; if (m < M) {
            const float rstd = rsqrtf(s[q] * (1.f / DM) + EPS);
            unsigned long long* o8 = (unsigned long long*)(H + (size_t)m * DM) + lane;
#pragma unroll
            for (int j = 0; j < 4; ++j) { const f32x4 y = v[q][j] * gv[j] * rstd; __builtin_nontemporal_store((unsigned long long)pk2(y[0], y[1]) | ((unsigned long long)pk2(y[2], y[3]) << 32), o8 + 64 * j); } } }
    }
    convert_items(p, lds, 0, CONV_EARLY, gw, NGW, wave, lane);
}

struct AttnP { const bf16_t *Qa, *Kn, *Kpe, *Vta, *Qd, *Kd, *Vtd; bf16_t* O; const float* subln_g; };
__device__ __forceinline__ bf16x8 packp(const f32x16& p, int b) {
    u32x4 w; w.x = pk2(p[b], p[b + 1]); w.y = pk2(p[b + 2], p[b + 3]); w.z = pk2(p[b + 4], p[b + 5]); w.w = pk2(p[b + 6], p[b + 7]);
    return __builtin_bit_cast(bf16x8, w);
}
template <bool DIFF> __device__ __forceinline__ void attn_unit(LAS unsigned char* lds, const AttnP& P, int b, int h, int qb, float lam, const int wave_s, const int VAR = 0) {
    constexpr int DQK = DIFF ? 64 : 96, DV = DIFF ? 128 : 64, QROWS = DIFF ? 128 : 256, NDB = DV / 32, NS = DQK / 16;
    constexpr int STAGE = DIFF ? 32768 : 20480, V_OFF = DIFF ? 16384 : 12288, NSLOT = 4;
    static_assert(NSLOT * STAGE <= 131072 && 4 * 128 * 32 * 4 <= NSLOT * STAGE + 32768, "attention LDS");
    int tid_ = wave_s * 64 + lane_fresh(); asm volatile("" : "+v"(tid_));
    const int tid = tid_, lane = tid & 63, wid = __builtin_amdgcn_readfirstlane(tid >> 6), r32 = lane & 31, hi = lane >> 5;
    const int map = DIFF ? (wid >> 2) : 0, wq = DIFF ? (wid & 3) : wid;
    const int q0 = qb * QROWS, qw_min = q0 + 32 * wq, qrow = qw_min + r32;
    const size_t mrow0 = (size_t)b * SEQ;
    const bf16_t* Qp = DIFF ? P.Qd + (mrow0 + qrow) * 512 + h * 128 + map * 64 : P.Qa + (mrow0 + qrow) * 768 + h * 96;
    bf16x8 qf[NS];
#pragma unroll
    for (int s = 0; s < NS; ++s) qf[s] = *(const bf16x8*)(Qp + 16 * s + 8 * hi);
    const int NT = (VAR & 16) ? 2 : (q0 + QROWS) / 64, tl = (qw_min + 31) >> 6;
    const char* src[4]; int dsto[4]; int strd[4]; int nops;
    if (DIFF) {
        nops = 4;
#pragma unroll
        for (int i = 0; i < 2; ++i) { const int j = wid + 8 * i, row = 4 * j + (lane >> 4), c = (lane & 15) ^ (row & 15);
            src[i] = (const char*)(P.Kd + (mrow0 + row) * 512 + h * 128 + c * 8); dsto[i] = j * 1024; strd[i] = 65536; }
#pragma unroll
        for (int i = 0; i < 2; ++i) { const int j = wid + 8 * i, d = 8 * j + (lane >> 3), c = (lane & 7) ^ ((d >> 1) & 7);
            src[2 + i] = (const char*)(P.Vtd + (size_t)(h * 128 + d) * M + mrow0 + c * 8); dsto[2 + i] = V_OFF + j * 1024; strd[2 + i] = 128; }
    } else {
        nops = wid < 4 ? 3 : 2;
        { const int row = 8 * wid + (lane >> 3), c = (lane & 7) ^ ((row >> 1) & 7);
          src[0] = (const char*)(P.Kn + (mrow0 + row) * 512 + h * 64 + c * 8); dsto[0] = wid * 1024; strd[0] = 65536; }
        const int jv1 = wid < 4 ? wid + 4 : wid - 4;
        const int dv_ = 8 * jv1 + (lane >> 3), cv_ = (lane & 7) ^ ((dv_ >> 1) & 7);
        const char* vsrc = (const char*)(P.Vta + (size_t)(h * 64 + dv_) * M + mrow0 + cv_ * 8);
        const int prow = 16 * (wid & 3) + (lane >> 2), pc = (lane & 3) ^ ((prow >> 2) & 3);
        const char* psrc = (const char*)(P.Kpe + (mrow0 + prow) * 32 + pc * 8);
        if (wid < 4) { src[1] = psrc; dsto[1] = 8192 + wid * 1024; strd[1] = 4096; src[2] = vsrc; dsto[2] = V_OFF + jv1 * 1024; strd[2] = 128; }
        else { src[1] = vsrc; dsto[1] = V_OFF + jv1 * 1024; strd[1] = 128; src[2] = vsrc; dsto[2] = 0; strd[2] = 0; }
        src[3] = vsrc; dsto[3] = 0; strd[3] = 0;
    }
#define ATT_DMA(t, slot) do { if (!(VAR & 1)) _Pragma("unroll") for (int i_ = 0; i_ < 4; ++i_) if (i_ < nops) \
        __builtin_amdgcn_global_load_lds((const unsigned*)(src[i_] + (size_t)(t) * strd[i_]), (LAS unsigned*)(lds + (slot) * STAGE + dsto[i_]), 16, 0, 0); } while (0)
    const int x16 = r32 & 15, pi = (r32 & 16) + ((x16 < 4 || x16 >= 12) ? x16 : (x16 < 8 ? x16 + 4 : x16 - 4));
    int kaddr[NS], vaddr[4];
#pragma unroll
    for (int s = 0; s < NS; ++s) {
        if (DIFF) kaddr[s] = pi * 256 + (((8 * map + 2 * s + hi) ^ (pi & 15)) << 4);
        else if (s < 4) kaddr[s] = pi * 128 + (((2 * s + hi) ^ ((pi >> 1) & 7)) << 4);
        else kaddr[s] = 8192 + pi * 64 + (((2 * (s - 4) + hi) ^ ((pi >> 2) & 3)) << 4);
    }
#pragma unroll
    for (int a = 0; a < 4; ++a) vaddr[a] = V_OFF + r32 * 128 + (((2 * a + hi) ^ ((r32 >> 1) & 7)) << 4);
    f32x16 o[NDB];
#pragma unroll
    for (int d = 0; d < NDB; ++d)
#pragma unroll
        for (int r = 0; r < 16; ++r) o[d][r] = 0.f;
    float mref = 0.f, lsum = 0.f;
    f32x16 negm;
#pragma unroll
    for (int r = 0; r < 16; ++r) negm[r] = 0.f;
    __builtin_amdgcn_s_waitcnt(0);
    ATT_DMA(0, 0); ATT_DMA(1, 1);
#define SBAR() __builtin_amdgcn_sched_barrier(0)
#define MX3(a, b, c) __builtin_fmaxf(__builtin_fmaxf((a), (b)), (c))
#define ATT_WAIT(t) do { if (VAR & 1) {} else if ((t) + 1 < NT) { if (DIFF) asm volatile("s_waitcnt vmcnt(4)" ::: "memory"); else if (wid < 4) asm volatile("s_waitcnt vmcnt(3)" ::: "memory"); else asm volatile("s_waitcnt vmcnt(2)" ::: "memory"); } \
        else asm volatile("s_waitcnt vmcnt(0)" ::: "memory"); if (!(VAR & 4)) __builtin_amdgcn_s_barrier(); asm volatile("" ::: "memory"); } while (0)
#define ATT_QK(P0, P1, kb) do { _Pragma("unroll") for (int s = 0; s < NS; ++s) { const int pbo = DIFF ? 8192 : (s < 4 ? 4096 : 2048); \
            const bf16x8 k0 = *(const LAS bf16x8*)((kb) + kaddr[s]), k1 = *(const LAS bf16x8*)((kb) + kaddr[s] + pbo); \
            if (s == 0) { if (DIFF) { f32x16 z; _Pragma("unroll") for (int r = 0; r < 16; ++r) z[r] = 0.f; P0 = __builtin_amdgcn_mfma_f32_32x32x16_bf16(k0, qf[0], z, 0, 0, 0); P1 = __builtin_amdgcn_mfma_f32_32x32x16_bf16(k1, qf[0], z, 0, 0, 0); } \
                          else { P0 = __builtin_amdgcn_mfma_f32_32x32x16_bf16(k0, qf[0], negm, 0, 0, 0); P1 = __builtin_amdgcn_mfma_f32_32x32x16_bf16(k1, qf[0], negm, 0, 0, 0); } } \
            else { P0 = __builtin_amdgcn_mfma_f32_32x32x16_bf16(k0, qf[s], P0, 0, 0, 0); P1 = __builtin_amdgcn_mfma_f32_32x32x16_bf16(k1, qf[s], P1, 0, 0, 0); } } } while (0)
#define ATT_MASK(P0, P1, t) do { if (64 * (t) + 63 > qw_min) { const int kv0 = 64 * (t) + 8 * hi; \
            _Pragma("unroll") for (int r = 0; r < 16; ++r) { const int kv = kv0 + 16 * (r >> 3) + (r & 7); if (kv > qrow) P0[r] = -INFINITY; if (kv + 32 > qrow) P1[r] = -INFINITY; } } } while (0)
#define ATT_ROWMAX(rm, P0, P1) do { float ma = MX3(P0[0], P0[1], P1[0]), mb = MX3(P0[2], P0[3], P1[1]); ma = MX3(ma, P1[2], P1[3]); \
            _Pragma("unroll") for (int r = 4; r < 16; r += 4) { ma = MX3(ma, P0[r], P0[r + 1]); mb = MX3(mb, P0[r + 2], P0[r + 3]); ma = MX3(ma, P1[r], P1[r + 1]); mb = MX3(mb, P1[r + 2], P1[r + 3]); } \
            rm = fmaxf(ma, mb); rm = fmaxf(rm, shx(rm, 32)); } while (0)
#define ATT_SUB(P0, P1, v) do { const pg8::f32x2 m2_ = {(v), (v)}; _Pragma("unroll") for (int r = 0; r < 16; r += 2) { pg8::f32x2 a_ = {P0[r], P0[r + 1]}, b_ = {P1[r], P1[r + 1]}; a_ -= m2_; b_ -= m2_; P0[r] = a_[0]; P0[r + 1] = a_[1]; P1[r] = b_[0]; P1[r + 1] = b_[1]; } } while (0)
#define ATT_EXP(P0, P1) do { if (!(VAR & 2)) _Pragma("unroll") for (int r = 0; r < 16; ++r) { P0[r] = __builtin_amdgcn_exp2f(P0[r]); P1[r] = __builtin_amdgcn_exp2f(P1[r]); } } while (0)
#define ATT_SUMPACK(P0, P1) do { pg8::f32x2 s2 = {0.f, 0.f}; _Pragma("unroll") for (int r = 0; r < 16; r += 2) { s2 += (pg8::f32x2){P0[r], P0[r + 1]}; s2 += (pg8::f32x2){P1[r], P1[r + 1]}; } lsum += s2[0] + s2[1]; \
            pk[0] = packp(P0, 0); pk[1] = packp(P0, 8); pk[2] = packp(P1, 0); pk[3] = packp(P1, 8); } while (0)
#define ATT_PV(kb) do { if (!(VAR & 8)) _Pragma("unroll") for (int d = 0; d < NDB; ++d) _Pragma("unroll") for (int a = 0; a < 4; ++a) { \
            const bf16x8 vf = *(const LAS bf16x8*)((kb) + vaddr[a] + d * 4096); o[d] = __builtin_amdgcn_mfma_f32_32x32x16_bf16(vf, pk[a], o[d], 0, 0, 0); } } while (0)
    f32x16 pa0, pa1, pb0, pb1; bf16x8 pk[4];
    ATT_WAIT(0);
    if (2 < NT) ATT_DMA(2, 2);
    { ATT_QK(pa0, pa1, lds); ATT_MASK(pa0, pa1, 0); float rm; ATT_ROWMAX(rm, pa0, pa1); mref = rm; ATT_SUB(pa0, pa1, rm);
      if (!DIFF) { _Pragma("unroll") for (int r = 0; r < 16; ++r) negm[r] = -mref; }
      ATT_EXP(pa0, pa1); }
    float fpend = 1.f; bool rpend = false;
    for (int t = 1; t < NT; ++t) {
        ATT_WAIT(t);
        if (t + 2 < NT) ATT_DMA(t + 2, (t + 2) & 3);
        const LAS unsigned char* kc = lds + (t & 3) * STAGE; const LAS unsigned char* kp = lds + ((t - 1) & 3) * STAGE;
        if (rpend) {
#pragma unroll
            for (int d = 0; d < NDB; ++d)
#pragma unroll
                for (int r = 0; r < 16; ++r) o[d][r] *= fpend;
        }
        const bool live = t <= tl, plive = t - 1 <= tl;
        SBAR();
        if (live) ATT_QK(pb0, pb1, kc);
        if (plive) ATT_SUMPACK(pa0, pa1);
        SBAR();
        float f = 1.f; bool resc = false;
        if (live) {
            ATT_MASK(pb0, pb1, t);
            float rm; ATT_ROWMAX(rm, pb0, pb1);
            if (DIFF) { const float rel = rm - mref; resc = __any(rel > 8.0f); if (resc) { const float dl = fmaxf(rel, 0.f); f = __builtin_amdgcn_exp2f(-dl); mref += dl; lsum *= f; } ATT_SUB(pb0, pb1, mref); }
            else { resc = __any(rm > 8.0f); if (resc) { const float dl = fmaxf(rm, 0.f); f = __builtin_amdgcn_exp2f(-dl); mref += dl; lsum *= f; ATT_SUB(pb0, pb1, dl); _Pragma("unroll") for (int r = 0; r < 16; ++r) negm[r] = -mref; } }
        }
        SBAR();
        if (plive) ATT_PV(kp);
        if (live) ATT_EXP(pb0, pb1);
        SBAR();
        rpend = resc; fpend = f;
        pa0 = pb0; pa1 = pb1;
    }
    if (rpend) {
#pragma unroll
        for (int d = 0; d < NDB; ++d)
#pragma unroll
            for (int r = 0; r < 16; ++r) o[d][r] *= fpend;
    }
    if (NT - 1 <= tl) { ATT_SUMPACK(pa0, pa1); ATT_PV(lds + ((NT - 1) & 3) * STAGE); }
#undef ATT_DMA
#undef ATT_WAIT
#undef ATT_QK
#undef ATT_MASK
#undef ATT_ROWMAX
#undef ATT_SUB
#undef ATT_EXP
#undef ATT_SUMPACK
#undef ATT_PV
#undef MX3
#undef SBAR
    asm volatile("s_waitcnt lgkmcnt(0)" ::: "memory"); __builtin_amdgcn_s_barrier(); asm volatile("" ::: "memory");
    const float inv = 1.f / (lsum + shx(lsum, 32));
    if (!DIFF) {
        bf16_t* Op = P.O + (mrow0 + qrow) * 1024 + h * 64;
#pragma unroll
        for (int d = 0; d < NDB; ++d)
#pragma unroll
            for (int g = 0; g < 4; ++g) {
                u32x2 w; w.x = pk2(o[d][4 * g] * inv, o[d][4 * g + 1] * inv); w.y = pk2(o[d][4 * g + 2] * inv, o[d][4 * g + 3] * inv);
                *(u32x2*)(Op + 32 * d + 8 * g + 4 * hi) = w;
            }
    } else {
        LAS float* X = (LAS float*)lds;
        if (map == 1) {
#pragma unroll
            for (int d = 0; d < NDB; ++d)
#pragma unroll
                for (int r = 0; r < 16; ++r) { const int dd = 32 * d + (r & 3) + 8 * (r >> 2) + 4 * hi; X[(wq * 128 + dd) * 32 + r32] = o[d][r] * inv; }
        }
        asm volatile("s_waitcnt lgkmcnt(0)" ::: "memory"); __builtin_amdgcn_s_barrier(); asm volatile("" ::: "memory");
        if (map == 0) {
            float ss = 0.f;
#pragma unroll
            for (int d = 0; d < NDB; ++d)
#pragma unroll
                for (int r = 0; r < 16; ++r) { const int dd = 32 * d + (r & 3) + 8 * (r >> 2) + 4 * hi; const float v = o[d][r] * inv - lam * X[(wq * 128 + dd) * 32 + r32]; o[d][r] = v; ss += v * v; }
            ss += shx(ss, 32);
            const float rs = rsqrtf(ss * (1.f / 128.f) + EPS) * 0.8f;
            bf16_t* Op = P.O + (mrow0 + qrow) * 1024 + 512 + h * 128;
#pragma unroll
            for (int d = 0; d < NDB; ++d)
#pragma unroll
                for (int g = 0; g < 4; ++g) {
                    const int dd = 32 * d + 8 * g + 4 * hi; const f32x4 sg = *(const f32x4*)(P.subln_g + dd);
                    u32x2 w; w.x = pk2(o[d][4 * g] * rs * sg[0], o[d][4 * g + 1] * rs * sg[1]); w.y = pk2(o[d][4 * g + 2] * rs * sg[2], o[d][4 * g + 3] * rs * sg[3]);
                    *(u32x2*)(Op + dd) = w;
                }
        }
        asm volatile("s_waitcnt lgkmcnt(0)" ::: "memory"); __builtin_amdgcn_s_barrier(); asm volatile("" ::: "memory");
    }
}

#ifndef REP0
#define REP0 1
#endif
#ifndef REP1
#define REP1 1
#endif
#ifndef REP2
#define REP2 1
#endif
#ifndef REP3
#define REP3 1
#endif
#ifndef REP4
#define REP4 1
#endif
#ifndef REP5
#define REP5 1
#endif
#ifndef SKIP0
#define SKIP0 0
#endif
#ifndef SKIP1
#define SKIP1 0
#endif
#ifndef SKIP2
#define SKIP2 0
#endif
#ifndef SKIP3
#define SKIP3 0
#endif
#ifndef SKIP4
#define SKIP4 0
#endif
#ifndef SKIP5
#define SKIP5 0
#endif
#ifndef SKIP6
#define SKIP6 0
#endif
#ifndef SKIP7
#define SKIP7 0
#endif
#define XB_TMO      128
#define XB_XCNT(j)  (256  + 64 * (j))
#define XB_XSUB(j)  (1280 + 64 * (j))
#define XB_XGEN(j)  (2304 + 64 * (j))
#define XB_TOP      3328
#define XB_TOPGEN   3392
#define XCD_BAR_WORDS 3456
#define XB_SPIN_CAP (1u << 18)

__device__ __forceinline__ unsigned xb_ld(unsigned* p)              { return __hip_atomic_load(p, __ATOMIC_RELAXED, __HIP_MEMORY_SCOPE_AGENT); }
__device__ __forceinline__ unsigned xb_add(unsigned* p, unsigned v) { return __hip_atomic_fetch_add(p, v, __ATOMIC_RELAXED, __HIP_MEMORY_SCOPE_AGENT); }
__device__ __forceinline__ unsigned xb_xcc_id() { return (unsigned)__builtin_amdgcn_s_getreg((3 << 11) | 20) & 0xFu; }
#define XB_SPIN(cond, bar) do { unsigned _sp = 0; while (cond) { __builtin_amdgcn_s_sleep(1); \
    if ((++_sp & 255u) == 0u) { if (xb_ld(&(bar)[XB_TMO])) break; if (_sp > XB_SPIN_CAP) { atomicAdd(&(bar)[XB_TMO], 1u); break; } } } } while (0)

struct XcdBarrier {
    unsigned* bar; unsigned x;
    volatile LAS unsigned* st;
};

__device__ __forceinline__ XcdBarrier xcd_barrier_post(unsigned* bar, volatile LAS unsigned* st, bool t0) {
    XcdBarrier b; b.bar = bar; b.x = xb_xcc_id(); b.st = st;
    if (t0) (void)xb_add(&bar[XB_XCNT(b.x)], 1u);
    return b;
}
__device__ __forceinline__ void xcd_barrier_complete(unsigned* bar, unsigned x, unsigned& nloc, unsigned& nx) {
    const unsigned G = gridDim.x * gridDim.y * gridDim.z;
    unsigned sum, cnt, mine, sp = 0u;
    for (;;) {
        sum = 0u; cnt = 0u; mine = 0u;
#pragma unroll
        for (unsigned j = 0; j < 16; ++j) { const unsigned c = xb_ld(&bar[XB_XCNT(j)]); sum += c; cnt += (c > 0u) ? 1u : 0u; mine = (j == x) ? c : mine; }
        if (sum == G) break;
        __builtin_amdgcn_s_sleep(1);
        if ((++sp & 255u) == 0u) { if (xb_ld(&bar[XB_TMO])) break; if (sp > XB_SPIN_CAP) { atomicAdd(&bar[XB_TMO], 1u); break; } }
    }
    nloc = mine > 0u ? mine : 1u; nx = cnt > 0u ? cnt : 1u;
}

__device__ __forceinline__ void xcd_barrier(const XcdBarrier& b, bool t0) {
    asm volatile("s_waitcnt vmcnt(0)" ::: "memory");
    __syncthreads();
    if (t0) {
        unsigned* bar = b.bar;
        __builtin_amdgcn_s_waitcnt(0);
        unsigned nloc = b.st[0], nx = b.st[1];
        if (nloc == 0u) { xcd_barrier_complete(bar, b.x, nloc, nx); b.st[0] = nloc; b.st[1] = nx; }
        const unsigned old = xb_add(&bar[XB_XSUB(b.x)], 1u);
        const unsigned gen = old / nloc;
        if (old + 1u == (gen + 1u) * nloc) {
            __builtin_amdgcn_fence(__ATOMIC_RELEASE, "agent");
            asm volatile("s_waitcnt vmcnt(0)" ::: "memory");
            const unsigned og = xb_add(&bar[XB_TOP], 1u);
            const unsigned tg = og / nx;
            if (og + 1u == (tg + 1u) * nx) xb_add(&bar[XB_TOPGEN], 1u);
            else XB_SPIN(xb_ld(&bar[XB_TOPGEN]) == tg, bar);
            __builtin_amdgcn_fence(__ATOMIC_ACQUIRE, "agent");
            xb_add(&bar[XB_XGEN(b.x)], 1u);
            asm volatile("s_waitcnt vmcnt(0)" ::: "memory");
        } else {
            XB_SPIN(xb_ld(&bar[XB_XGEN(b.x)]) == gen, bar);
            __builtin_amdgcn_fence(__ATOMIC_ACQUIRE, "agent");
            asm volatile("s_waitcnt vmcnt(0)" ::: "memory");
        }
    }
    __syncthreads();
}

template <class F> __device__ __forceinline__ void xcd_barrier_preload(const XcdBarrier& b, bool t0, bool proto_wave, const F& hook) {
    asm volatile("s_waitcnt vmcnt(0)" ::: "memory");
    __syncthreads();
    if (!proto_wave) hook();
    if (t0) {
        unsigned* bar = b.bar;
        __builtin_amdgcn_s_waitcnt(0);
        unsigned nloc = b.st[0], nx = b.st[1];
        if (nloc == 0u) { xcd_barrier_complete(bar, b.x, nloc, nx); b.st[0] = nloc; b.st[1] = nx; }
        const unsigned old = xb_add(&bar[XB_XSUB(b.x)], 1u);
        const unsigned gen = old / nloc;
        if (old + 1u == (gen + 1u) * nloc) {
            __builtin_amdgcn_fence(__ATOMIC_RELEASE, "agent");
            asm volatile("s_waitcnt vmcnt(0)" ::: "memory");
            const unsigned og = xb_add(&bar[XB_TOP], 1u);
            const unsigned tg = og / nx;
            if (og + 1u == (tg + 1u) * nx) xb_add(&bar[XB_TOPGEN], 1u);
            else XB_SPIN(xb_ld(&bar[XB_TOPGEN]) == tg, bar);
            __builtin_amdgcn_fence(__ATOMIC_ACQUIRE, "agent");
            xb_add(&bar[XB_XGEN(b.x)], 1u);
            asm volatile("s_waitcnt vmcnt(0)" ::: "memory");
        } else {
            XB_SPIN(xb_ld(&bar[XB_XGEN(b.x)]) == gen, bar);
            __builtin_amdgcn_fence(__ATOMIC_ACQUIRE, "agent");
            asm volatile("s_waitcnt vmcnt(0)" ::: "memory");
        }
    }
    if (proto_wave) hook();
    __syncthreads();
}
struct PreloadX {
    const float* x; pg8::Unit u; int wave_s; pg8::f32x4 (&pre)[2][2][4][2];
    __device__ __forceinline__ void operator()() const {
        int tid_ = wave_s * 64 + lane_fresh(); asm volatile("" : "+v"(tid_));
        const int lane = tid_ & 63, wr = wave_s >> 2, wc = wave_s & 3, fr = lane & 15, fq = lane >> 4;
        const int col0 = u.pn * 256 + wc * 32 + 4 * fq;
#pragma unroll
        for (int ai = 0; ai < 2; ++ai)
#pragma unroll
            for (int m = 0; m < 4; ++m) {
                const size_t off = (size_t)(u.pm * 256 + ai * 128 + wr * 64 + m * 16 + fr) * DM + col0;
#pragma unroll
                for (int bj = 0; bj < 2; ++bj)
#pragma unroll
                    for (int n = 0; n < 2; ++n) pre[ai][bj][m][n] = *(const pg8::f32x4*)(x + off + bj * 128 + n * 16);
            }
    }
};
struct PreloadX1 {
    const bf16_t* x1; pg8::Unit u; int wave_s; pg8::u32x2 (&pre)[2][2][4][2];
    __device__ __forceinline__ void operator()() const {
        int tid_ = wave_s * 64 + lane_fresh(); asm volatile("" : "+v"(tid_));
        const int lane = tid_ & 63, wr = wave_s >> 2, wc = wave_s & 3, fr = lane & 15, fq = lane >> 4;
        const int col0 = u.pn * 256 + wc * 32 + 4 * fq;
#pragma unroll
        for (int ai = 0; ai < 2; ++ai)
#pragma unroll
            for (int m = 0; m < 4; ++m) {
                const size_t off = (size_t)(u.pm * 256 + ai * 128 + wr * 64 + m * 16 + fr) * DM + col0;
#pragma unroll
                for (int bj = 0; bj < 2; ++bj)
#pragma unroll
                    for (int n = 0; n < 2; ++n) pre[ai][bj][m][n] = *(const pg8::u32x2*)(x1 + off + bj * 128 + n * 16);
            }
    }
};
__global__ void __launch_bounds__(NTHR, 2) fwd_megakernel(Params p) {
    extern __shared__ __attribute__((aligned(16))) unsigned char lds_raw[];
    LAS unsigned char* lds = (LAS unsigned char*)lds_raw;
    cg::grid_group grid = cg::this_grid();
    const int G = gridDim.x, bx = blockIdx.x;
    const int wave_s = __builtin_amdgcn_readfirstlane((int)threadIdx.x >> 6);
#define FRESH_TID() (wave_s * 64 + lane_fresh())
    const int vcu = (G % 8 == 0) ? (bx % 8) * (G / 8) + bx / 8 : bx;
    unsigned char* ws = p.ws;
    const int lo = p.ph_lo, hi = p.ph_hi;
#define IN(k) (lo <= (k) && (k) < hi)
#define SEAM(k) do { if (IN(k) && IN((k) + 1)) { if ((k) == 0 && p.ph_hi == 0x7fffffff) grid.sync();   xcd_barrier(xbar, FRESH_TID() == 0); } } while (0)
    { const int t_ = FRESH_TID(); if (t_ < 2) ((volatile LAS unsigned*)(lds + 131072 + 8192))[t_] = 0u; }
    __syncthreads();
    XcdBarrier xbar; xbar.bar = (unsigned*)(ws + WS_CTL); xbar.x = 0; xbar.st = nullptr;
    if (hi - lo > 2) xbar = xcd_barrier_post((unsigned*)(ws + WS_CTL), (volatile LAS unsigned*)(lds + 131072 + 8192), FRESH_TID() == 0);
    bf16_t* H = (bf16_t*)(ws + WS_H);
    float* ropeA = (float*)(ws + WS_ROPEA); float* ropeB = (float*)(ws + WS_ROPEB);
    float* ssq_q = (float*)(ws + WS_SSQQ); float* ssq_x1 = (float*)(ws + WS_SSQX);
    bf16_t* CQ = (bf16_t*)(ws + WS_CQ); bf16_t* CKV = (bf16_t*)(ws + WS_CKV); bf16_t* Qa = (bf16_t*)(ws + WS_QA); bf16_t* Ka = (bf16_t*)(ws + WS_KA); bf16_t* Kpe = (bf16_t*)(ws + WS_KA + 16 * MiB); bf16_t* Vta = (bf16_t*)(ws + WS_VTA);
    bf16_t* Qd = (bf16_t*)(ws + WS_QD); bf16_t* Kd = (bf16_t*)(ws + WS_KD); bf16_t* Vtd = (bf16_t*)(ws + WS_VTD); bf16_t* O = (bf16_t*)(ws + WS_O);
    bf16_t* Abuf = (bf16_t*)(ws + WS_ABUF); float* HL = (float*)(ws + WS_HL);

#ifdef PROBE_PHASE
    unsigned long long pt0_ = 0;
#define PB(k) do { if ((k) == PROBE_PHASE) pt0_ = __builtin_amdgcn_s_memrealtime(); } while (0)
#define PE(k) do { if ((k) == PROBE_PHASE) { const unsigned long long t1_ = __builtin_amdgcn_s_memrealtime(); while (__builtin_amdgcn_s_memrealtime() - t1_ < t1_ - pt0_) __builtin_amdgcn_s_sleep(8); } } while (0)
#else
#define PB(k) do {} while (0)
#define PE(k) do {} while (0)
#endif
    PB(0);
    if (IN(0) && !SKIP0) for (int rep_ = 0; rep_ < REP0; ++rep_) { int t0_ = FRESH_TID(); asm volatile("" : "+v"(t0_)); p0_prologue(p, lds, vcu, G, __builtin_amdgcn_readfirstlane(t0_ >> 6), t0_ & 63); }
    SEAM(0);
    PE(0); PB(1);
    if (IN(1) && !SKIP1) for (int rep_ = 0; rep_ < REP1; ++rep_) {
        { pg8::Gemm g{H, (const bf16_t*)(ws + WS_WIN), M, 1792, 1024}; pg8::StaticOrder S; S.init(M, 1792, G, bx);
          pg8::EpiInProj E{CQ, CKV, Kpe, Qd, Kd, ssq_q, p.in[8], p.in[9], p.in[10], ropeA, ropeB, QSCALE_D, (LAS float*)(lds + 131072), (unsigned*)(ws + WS_CTL + 16384), (unsigned*)(ws + WS_CTL + 16384 + 64 * 256)};
          pg8::gemm_phase<pg8::EpiInProj, pg8::StaticOrder, true, true>(lds, g, S, E, wave_s); }
        { pg8::Gemm g{(const bf16_t*)(ws + WS_WDV), H, 512, M, 1024}; pg8::StaticOrder S; S.init(512, M, G, (bx + G - G / 2) % G);
          pg8::EpiStoreT E{Vtd, M};
          pg8::gemm_phase<pg8::EpiStoreT, pg8::StaticOrder, true, true>(lds, g, S, E, wave_s); }
    }
    if (IN(1) && !SKIP2) {
        unsigned* cntq = (unsigned*)(ws + WS_CTL + 16384); unsigned* cntkv = (unsigned*)(ws + WS_CTL + 16384 + 64 * 256);
#define PANEL_WAIT(cnt, pan, want) do { unsigned sp_ = 0; while (__hip_atomic_load((cnt) + 64 * (pan), __ATOMIC_RELAXED, __HIP_MEMORY_SCOPE_AGENT) < (want)) { __builtin_amdgcn_s_sleep(2); if (++sp_ > (1u << 22)) break; } \
        __builtin_amdgcn_fence(__ATOMIC_ACQUIRE, "workgroup"); asm volatile("" ::: "memory"); } while (0)
        { pg8::Gemm g{CQ, (const bf16_t*)(ws + WS_WQ), M, 768, 384}; pg8::StaticOrder S; S.init(M, 768, G, (bx + G / 4) % G);
          pg8::Unit u0; if (S.next(0, u0)) PANEL_WAIT(cntq, u0.pm, 16u);
          pg8::EpiQUp E{Qa, ssq_q, p.in[7], ropeA, QSCALE_A};
          pg8::gemm_phase<pg8::EpiQUp, pg8::StaticOrder, true, true>(lds, g, S, E, wave_s); }
        { pg8::Gemm g{CKV, (const bf16_t*)(ws + WS_WK), M, 512, 256}; pg8::StaticOrder S; S.init(M, 512, G, bx);
          pg8::Unit u0; if (S.next(0, u0)) PANEL_WAIT(cntkv, u0.pm, 8u);
          pg8::EpiKUp E{Ka, p.in[8]};
          pg8::gemm_phase<pg8::EpiKUp, pg8::StaticOrder, true, true>(lds, g, S, E, wave_s); }
        { pg8::Gemm g{(const bf16_t*)(ws + WS_WV), CKV, 512, M, 256}; pg8::StaticOrder S; S.init(512, M, G, (bx + G / 4) % G);
          pg8::Unit u0; if (S.next(0, u0)) PANEL_WAIT(cntkv, u0.pn, 8u);
          pg8::EpiStoreT E{Vta, M};
          pg8::gemm_phase<pg8::EpiStoreT, pg8::StaticOrder, true, true>(lds, g, S, E, wave_s); }
#undef PANEL_WAIT
        if (G == 256 && bx >= 64) { int t1_ = FRESH_TID(); asm volatile("" : "+v"(t1_)); const int w1_ = __builtin_amdgcn_readfirstlane(t1_ >> 6);
            convert_items(p, lds, CONV_EARLY, CONV_ALL - 44 * 32, (bx - 64) * NWAVES + w1_, 192 * NWAVES, w1_, t1_ & 63); }
    }
    do { if (IN(1) && IN(3)) { xcd_barrier(xbar, FRESH_TID() == 0); } } while (0);
    PE(1); PB(3);
    if (IN(3) && !SKIP3) for (int rep_ = 0; rep_ < REP3; ++rep_) {
        int t3_ = FRESH_TID(); asm volatile("" : "+v"(t3_)); const int lane = t3_ & 63;
        const float d1 = wave_sum(p.in[11][lane] * p.in[12][lane]), d2 = wave_sum(p.in[13][lane] * p.in[14][lane]);
        const float lam = __expf(d1) - __expf(d2) + 0.2f;
        if (rep_ == 0 && G != 256) {
            int t3b_ = FRESH_TID(); asm volatile("" : "+v"(t3b_)); const int w3_ = __builtin_amdgcn_readfirstlane(t3b_ >> 6);
            convert_items(p, lds, CONV_EARLY, (G == 256) ? CONV_ALL - 44 * 32 : CONV_ALL, vcu * NWAVES + w3_, G * NWAVES, w3_, t3b_ & 63);
            __syncthreads();
        }
        AttnP P{Qa, Ka, Kpe, Vta, Qd, Kd, Vtd, O, p.in[15]};
#ifdef ATT_VAR
        const int avar = (rep_ == 0) ? ATT_VAR : 0;
#else
        const int avar = 0;
#endif
        for (int su = vcu; su < 256; su += G) {
            { const int bh = su >> 2, s = su & 3; attn_unit<false>(lds, P, bh >> 3, bh & 7, 7 - s, 0.f, wave_s, avar); attn_unit<false>(lds, P, bh >> 3, bh & 7, s, 0.f, wave_s, avar); }
            { const int bh = su >> 3, s = su & 7; attn_unit<true>(lds, P, bh >> 2, bh & 3, 15 - s, lam, wave_s, avar); attn_unit<true>(lds, P, bh >> 2, bh & 3, s, lam, wave_s, avar); }
        }
    }
    pg8::f32x4 prex[2][2][4][2];
    bool have_prex = false;
    if (IN(3) && IN(4)) {
        pg8::StaticOrder S4; S4.init(M, 1024, G, bx); pg8::Unit u4; have_prex = S4.next(0, u4);
        if (have_prex) { PreloadX hook{p.in[0], u4, wave_s, prex}; xcd_barrier_preload(xbar, FRESH_TID() == 0, wave_s == 0, hook); }
        else xcd_barrier(xbar, FRESH_TID() == 0);
    }
    PE(3); PB(4);
#ifdef EXTRA_BAR
    xcd_barrier(xbar, FRESH_TID() == 0); xcd_barrier(xbar, FRESH_TID() == 0); xcd_barrier(xbar, FRESH_TID() == 0); xcd_barrier(xbar, FRESH_TID() == 0);
#endif
    if (IN(4) && !SKIP4) for (int rep_ = 0; rep_ < REP4; ++rep_) {
        pg8::Gemm g{O, (const bf16_t*)(ws + WS_WO), M, 1024, 1024}; pg8::StaticOrder S; S.init(M, 1024, G, bx);
        pg8::EpiWOut E{p.in[0], p.out, H, ssq_x1, prex, have_prex};
        pg8::gemm_phase<pg8::EpiWOut, pg8::StaticOrder, false, true>(lds, g, S, E, wave_s);
    }
    SEAM(4);
    PE(4); PB(5);
    if (IN(5) && !SKIP5) for (int rep_ = 0; rep_ < REP5; ++rep_) {
        pg8::Gemm g{H, (const bf16_t*)(ws + WS_WGU), M, 2 * FF, 1024}; pg8::StaticOrder S; S.init(M, 2 * FF, G, bx);
        pg8::EpiGateUp E{Abuf, HL, ssq_x1, p.in[20], p.in[21]};
        pg8::gemm_phase<pg8::EpiGateUp, pg8::StaticOrder, true, true>(lds, g, S, E, wave_s);
        if (G == 256 && bx >= 128 && rep_ == 0) {
            int t5_ = FRESH_TID(); asm volatile("" : "+v"(t5_)); const int w5_ = __builtin_amdgcn_readfirstlane(t5_ >> 6);
            convert_items(p, lds, CONV_ALL - 44 * 32, CONV_ALL, (bx - 128) * NWAVES + w5_, 128 * NWAVES, w5_, t5_ & 63);
        }
    }
    SEAM(5);
    PE(5); PB(6);
    if (IN(6) && !SKIP6) {
        const float* cw = p.in[20]; const float* cb = p.in[21];
        int tid = FRESH_TID(); asm volatile("" : "+v"(tid));
        for (int i = bx * NTHR + tid; i < 256 * 2 * (FF / 4); i += G * NTHR) {
            const int f = (i % (FF / 4)) * 4, rr = (i / (FF / 4)) & 1, kb = i / (2 * (FF / 4));
            const bool first = (kb & 31) == 0;
            const f32x4 z = (f32x4){0.f, 0.f, 0.f, 0.f};
            const f32x4 gt = *(const f32x4*)(HL + ((size_t)kb * 6 + 2 + rr) * FF + f), ut = *(const f32x4*)(HL + ((size_t)kb * 6 + 4 + rr) * FF + f);
            const f32x4 p63 = first ? z : *(const f32x4*)(HL + ((size_t)(kb - 1) * 6 + 1) * FF + f);
            f32x4 gm1, gm2;
            if (rr == 0) { gm1 = p63; gm2 = first ? z : *(const f32x4*)(HL + ((size_t)(kb - 1) * 6 + 0) * FF + f); }
            else { gm1 = *(const f32x4*)(HL + ((size_t)kb * 6 + 2) * FF + f); gm2 = p63; }
            const f32x4 w0 = *(const f32x4*)(cw + f), w1 = *(const f32x4*)(cw + FF + f), w2 = *(const f32x4*)(cw + 2 * FF + f), b4 = *(const f32x4*)(cb + f);
            f32x4 o;
#pragma unroll
            for (int j = 0; j < 4; ++j) { const float cv = w2[j] * gt[j] + w1[j] * gm1[j] + w0[j] * gm2[j] + b4[j]; o[j] = cv / (1.f + __expf(-cv)) * ut[j]; }
            pg8::store8(Abuf + (size_t)(kb * 64 + rr) * FF + f, pg8::pack4(o));
        }
    }
    pg8::u32x2 prew[2][2][4][2];
    bool have_prew = false;
    if (IN(6) && IN(7)) {
        pg8::StaticOrder S7; S7.init(M, 1024, G, bx); pg8::Unit u7; have_prew = S7.next(0, u7);
        if (have_prew) { PreloadX1 hook{H, u7, wave_s, prew}; xcd_barrier_preload(xbar, FRESH_TID() == 0, wave_s == 0, hook); }
        else xcd_barrier(xbar, FRESH_TID() == 0);
    }
    PE(6); PB(7);
    if (IN(7) && !SKIP7) {
        pg8::Gemm g{Abuf, (const bf16_t*)(ws + WS_WD), M, 1024, FF}; pg8::StaticOrder S; S.init(M, 1024, G, bx);
#ifdef REP7
        { pg8::EpiDown E0{H, (float*)(ws + WS_QD), prew, false}; pg8::gemm_phase<pg8::EpiDown, pg8::StaticOrder, false, true>(lds, g, S, E0, wave_s); }
#endif
        pg8::EpiDown E{H, p.out, prew, have_prew};
        pg8::gemm_phase<pg8::EpiDown, pg8::StaticOrder, false, true>(lds, g, S, E, wave_s);
    }
    PE(7);
#undef IN
#undef SEAM
}

#ifndef MK_N_LAUNCHES
#define MK_N_LAUNCHES 1
#endif
extern "C" void kernel_launch(void* const* d_in, const int* in_sizes, int n_in, void* d_out, int out_size, void* d_ws, size_t ws_size, hipStream_t stream) {
    static int grid = 0;
    if (grid == 0) {
        int dev = 0, cus = 0, per_cu = 0;
        hipGetDevice(&dev); hipDeviceGetAttribute(&cus, hipDeviceAttributeMultiprocessorCount, dev);
        hipFuncSetAttribute((const void*)fwd_megakernel, hipFuncAttributeMaxDynamicSharedMemorySize, LDS_BYTES);
        hipOccupancyMaxActiveBlocksPerMultiprocessor(&per_cu, (const void*)fwd_megakernel, NTHR, LDS_BYTES);
        (void)hipGetLastError();
        if (per_cu < 1) per_cu = 1;
        grid = cus * 1;
        if (grid <= 0) grid = 256;
    }
    Params p{};
    for (int i = 0; i < 23; ++i) p.in[i] = (const float*)d_in[i];
    p.out = (float*)d_out; p.ws = (unsigned char*)d_ws;
    for (int i = 0; i < 16; ++i) p.invA[i] = 1.0f / powf(10000.0f, (float)(2 * i) / 32.0f);
    for (int i = 0; i < 32; ++i) p.invB[i] = 1.0f / powf(10000.0f, (float)(2 * i) / 64.0f);
#if MK_N_LAUNCHES == 1
    p.ph_lo = 0; p.ph_hi = 8;
    hipMemsetAsync((char*)d_ws + WS_CTL, 0, CTL_BYTES, stream);
    void* args[] = {&p};
    hipError_t e = hipLaunchCooperativeKernel((const void*)fwd_megakernel, dim3(grid), dim3(NTHR), args, LDS_BYTES, stream);
    if (e != hipSuccess) fprintf(stderr, "cooperative launch failed: %s (grid %d)\n", hipGetErrorString(e), grid);
#else
    for (int ph = 0; ph < 8; ++ph) { p.ph_lo = ph; p.ph_hi = ph + 1; hipLaunchKernelGGL(fwd_megakernel, dim3(grid), dim3(NTHR), LDS_BYTES, stream, p); }
#endif
}
```

```cpp
#include <hip/hip_runtime.h>
#include <hip/hip_cooperative_groups.h>
#include <cstdio>
#include <cstdint>
#include <cmath>
namespace cg = cooperative_groups;

constexpr int BATCH = 8, SEQ = 2048, DM = 1024, M = BATCH * SEQ;
constexpr int FF = 2816;
constexpr float EPS = 1e-6f;
constexpr float LOG2E = 1.4426950408889634f;
constexpr float QSCALE_A = 0.10206207261596577f * LOG2E;
constexpr float QSCALE_D = 0.125f * LOG2E;

__device__ __forceinline__ int lane_fresh() { int l; asm volatile("v_mbcnt_lo_u32_b32 %0, -1, 0\n\tv_mbcnt_hi_u32_b32 %0, -1, %0" : "=v"(l)); return l; }
__device__ __forceinline__ float shx(float v, int mask) { const int idx = (lane_fresh() ^ mask) << 2; return __builtin_bit_cast(float, __builtin_amdgcn_ds_bpermute(idx, __builtin_bit_cast(int, v))); }
__device__ __forceinline__ float shl(float v, int src) { return __builtin_bit_cast(float, __builtin_amdgcn_ds_bpermute(src << 2, __builtin_bit_cast(int, v))); }
namespace pg8 {
#define PG8_LAS __attribute__((address_space(3)))
typedef unsigned short bf16_t;
typedef short bf16x8 __attribute__((ext_vector_type(8)));
typedef float f32x4 __attribute__((ext_vector_type(4)));
typedef unsigned u32x4 __attribute__((ext_vector_type(4)));
constexpr int BM = 256, BK = 64, HALF = 128, HTB = HALF * BK * 2  , STAGE_BYTES = 8 * HTB, NXCD = 8, WGM = 8;

__host__ __device__ __forceinline__ int lds_byte(int r, int c) { const int st = (r >> 4) * 2 + (c >> 5), rr = r & 15, cc = c & 31, ob = rr * 64 + cc * 2; return st * 1024 + (ob ^ (((ob >> 9) & 1) << 5)); }
__host__ __device__ __forceinline__ void stage_rc(int b, int& R, int& C) { const int st = b / 1024, sb = b % 1024, swz = sb ^ (((sb >> 9) & 1) << 5); R = (st >> 1) * 16 + swz / 64; C = (st & 1) * 32 + (swz % 64) / 2; }
__host__ __device__ __forceinline__ int perm32(int rho) { const int n = rho >> 4, i = rho & 15; return 8 * (i >> 2) + 4 * n + (i & 3); }

struct Unit { int pm, pn; };
struct Gemm { const bf16_t* A; const bf16_t* Bt; int M, N, K; };

struct StaticOrder {
    int nM, nN, nwg, G, c;
    __host__ __device__ void init(int M, int N, int G_, int c_) { nM = M / BM; nN = N / BM; nwg = nM * nN; G = G_; c = c_; }
    __host__ __device__ bool next(int i, Unit& u) const {
        const long L = (long)i * G + c; if (L >= nwg) return false;
        int wgid = (int)L; { const int q = nwg / NXCD, r = nwg % NXCD, xcd = wgid % NXCD, off = wgid / NXCD; wgid = (xcd < r ? xcd * (q + 1) : r * (q + 1) + (xcd - r) * q) + off; }
        const int nig = WGM * nN, gid = wgid / nig, fm = gid * WGM, gsz = (nM - fm) < WGM ? (nM - fm) : WGM;
        u.pm = fm + ((wgid % nig) % gsz); u.pn = (wgid % nig) / gsz; return true;
    }
    __device__ __forceinline__ void a_ready(const Unit&) const {}
    __device__ __forceinline__ void done(const Unit&) const {}
};

typedef unsigned u32x2 __attribute__((ext_vector_type(2)));
typedef float f32x2 __attribute__((ext_vector_type(2)));
typedef __bf16 bf16x2_t __attribute__((ext_vector_type(2)));
__device__ __forceinline__ unsigned cvt_pk_bf16(float lo, float hi) { f32x2 v = {lo, hi}; bf16x2_t b = __builtin_convertvector(v, bf16x2_t); return __builtin_bit_cast(unsigned, b); }
__device__ __forceinline__ u32x2 pack4(f32x4 v) { u32x2 w; w.x = cvt_pk_bf16(v[0], v[1]); w.y = cvt_pk_bf16(v[2], v[3]); return w; }
__device__ __forceinline__ void store8(bf16_t* p, u32x2 w) { *(u32x2*)p = w; }
__device__ __forceinline__ void store8_wt(bf16_t* p, u32x2 w) { __hip_atomic_store((unsigned long long*)p, (unsigned long long)w.x | ((unsigned long long)w.y << 32), __ATOMIC_RELAXED, __HIP_MEMORY_SCOPE_AGENT); }
__device__ __forceinline__ float dot4(f32x4 v) { return (v[0] * v[0] + v[1] * v[1]) + (v[2] * v[2] + v[3] * v[3]); }
__device__ __forceinline__ float red_fq(float s) { s += shx(s, 16); s += shx(s, 32); return s; }
constexpr float EPSN = 1e-6f;

struct EpiInProj {
    static constexpr bool PERM = false, AFTER_DRAIN = false, INIT = false;
    bf16_t *CQ, *CKV, *Kpe, *Qd, *Kd; float *ssq_q; const float *gk, *gdq, *gdk; const float* ropeA; const float* ropeB; float qscale_d; PG8_LAS float* part; unsigned* cntq; unsigned* cntkv;
    __device__ __forceinline__ void operator()(const f32x4 (&acc)[2][2][4][2], const Unit& u, int wr, int wc, int fr, int fq) const {
        asm volatile("" : "+v"(fr), "+v"(fq));
        const int pn = u.pn;
        if (pn == 2) {
#pragma unroll
            for (int ai = 0; ai < 2; ++ai)
#pragma unroll
                for (int m = 0; m < 4; ++m) {
                    float ss = 0.f;
#pragma unroll
                    for (int bj = 0; bj < 2; ++bj)
#pragma unroll
                        for (int n = 0; n < 2; ++n) ss += dot4(acc[ai][bj][m][n]);
                    ss = red_fq(ss);
                    if (fq == 0) part[(ai * HALF + wr * 64 + m * 16 + fr) * 4 + wc] = ss;
                }
            asm volatile("s_waitcnt lgkmcnt(0)" ::: "memory"); __builtin_amdgcn_s_barrier(); asm volatile("" ::: "memory");
#pragma unroll
            for (int ai = 0; ai < 2; ++ai)
#pragma unroll
                for (int m = 0; m < 4; ++m) {
                    const int rl = ai * HALF + wr * 64 + m * 16 + fr, row = u.pm * BM + rl;
                    const f32x4 q = *(const PG8_LAS f32x4*)(part + rl * 4);
                    const float rstd = rsqrtf(((q[0] + q[1]) + (q[2] + q[3])) * (1.f / 256.f) + EPSN);
                    bf16_t* dst = CKV + (size_t)row * 256 + 64 * wc;
#pragma unroll
                    for (int bj = 0; bj < 2; ++bj)
#pragma unroll
                        for (int n = 0; n < 2; ++n) store8_wt(dst + 32 * bj + 16 * n + 4 * fq, pack4(acc[ai][bj][m][n] * rstd));
                }
            asm volatile("s_waitcnt vmcnt(0)" ::: "memory");
            if (fr == 0 && fq == 0) __hip_atomic_fetch_add(cntkv + 64 * u.pm, 1u, __ATOMIC_RELAXED, __HIP_MEMORY_SCOPE_AGENT);
            return;
        }
#pragma unroll
        for (int ai = 0; ai < 2; ++ai)
#pragma unroll
            for (int m = 0; m < 4; ++m) {
                const int row = u.pm * BM + ai * HALF + wr * 64 + m * 16 + fr;
                if (pn < 2) {
                    if (pn != 1 || wc < 2) {
                        bf16_t* dst = CQ + (size_t)row * 384 + pn * 256 + 64 * wc;
                        float ss = 0.f;
#pragma unroll
                        for (int bj = 0; bj < 2; ++bj)
#pragma unroll
                            for (int n = 0; n < 2; ++n) { const f32x4 v = acc[ai][bj][m][n]; ss += dot4(v); store8_wt(dst + 32 * bj + 16 * n + 4 * fq, pack4(v)); }
                        ss = red_fq(ss);
                        if (fq == 0) __hip_atomic_store(ssq_q + (size_t)row * 8 + pn * 4 + wc, ss, __ATOMIC_RELAXED, __HIP_MEMORY_SCOPE_AGENT);
                    } else if (wc == 2) {
                        const f32x4 v0 = acc[ai][0][m][0], v1 = acc[ai][0][m][1];
                        float ss = red_fq(dot4(v0) + dot4(v1));
                        const float rstd = rsqrtf(ss * (1.f / 32.f) + EPSN);
                        const int s = row & (SEQ - 1);
                        const f32x4 g0 = *(const f32x4*)(gk + 64 + 4 * fq), g1 = *(const f32x4*)(gk + 80 + 4 * fq);
                        const f32x4 r0 = *(const f32x4*)(ropeA + (size_t)(s * 16 + 4 * fq) * 2), r1 = *(const f32x4*)(ropeA + (size_t)(s * 16 + 4 * fq) * 2 + 4);
                        const float cs[4] = {r0[0], r0[2], r1[0], r1[2]}, sn[4] = {r0[1], r0[3], r1[1], r1[3]};
                        f32x4 o1, o2;
#pragma unroll
                        for (int j = 0; j < 4; ++j) { const float x1 = v0[j] * rstd * g0[j], x2 = v1[j] * rstd * g1[j]; o1[j] = x1 * cs[j] - x2 * sn[j]; o2[j] = x2 * cs[j] + x1 * sn[j]; }
                        const u32x2 w1 = pack4(o1), w2 = pack4(o2);
                        store8(Kpe + (size_t)row * 32 + 4 * fq, w1); store8(Kpe + (size_t)row * 32 + 16 + 4 * fq, w2);
                    }
                } else {
                    const bool isq = pn < 5;
                    const int G8 = ((pn - 3) & 1) * 4 + wc;
                    const float* g = isq ? gdq : gdk;
                    bf16_t* dst = (isq ? Qd : Kd) + (size_t)row * 512 + G8 * 64;
                    float ss = 0.f;
#pragma unroll
                    for (int bj = 0; bj < 2; ++bj)
#pragma unroll
                        for (int n = 0; n < 2; ++n) ss += dot4(acc[ai][bj][m][n]);
                    ss = red_fq(ss);
                    const float rstd = rsqrtf(ss * (1.f / 64.f) + EPSN) * (isq ? qscale_d : 1.f);
                    const int s = row & (SEQ - 1);
#pragma unroll
                    for (int n = 0; n < 2; ++n) {
                        const int i0 = 16 * n + 4 * fq;
                        const f32x4 g0 = *(const f32x4*)(g + i0), g1 = *(const f32x4*)(g + 32 + i0);
                        const f32x4 r0 = *(const f32x4*)(ropeB + (size_t)(s * 32 + i0) * 2), r1 = *(const f32x4*)(ropeB + (size_t)(s * 32 + i0) * 2 + 4);
                        const float cs[4] = {r0[0], r0[2], r1[0], r1[2]}, sn[4] = {r0[1], r0[3], r1[1], r1[3]};
                        const f32x4 v0 = acc[ai][0][m][n], v1 = acc[ai][1][m][n];
                        f32x4 o1, o2;
#pragma unroll
                        for (int j = 0; j < 4; ++j) { const float x1 = v0[j] * rstd * g0[j], x2 = v1[j] * rstd * g1[j]; o1[j] = x1 * cs[j] - x2 * sn[j]; o2[j] = x2 * cs[j] + x1 * sn[j]; }
                        store8(dst + i0, pack4(o1)); store8(dst + 32 + i0, pack4(o2));
                    }
                }
            }
        if (pn < 2) {
            asm volatile("s_waitcnt vmcnt(0)" ::: "memory");
            if (fr == 0 && fq == 0) __hip_atomic_fetch_add(cntq + 64 * u.pm, 1u, __ATOMIC_RELAXED, __HIP_MEMORY_SCOPE_AGENT);
        }
    }
};

struct EpiStoreT {
    static constexpr bool PERM = false, AFTER_DRAIN = false, INIT = false;
    bf16_t* O; int ldo;
    __device__ __forceinline__ void operator()(const f32x4 (&acc)[2][2][4][2], const Unit& u, int wr, int wc, int fr, int fq) const {
        asm volatile("" : "+v"(fr), "+v"(fq));
        const int tok0 = u.pn * BM + wc * 32 + 4 * fq;
#pragma unroll
        for (int ai = 0; ai < 2; ++ai)
#pragma unroll
            for (int m = 0; m < 4; ++m) {
                const int row = u.pm * BM + ai * HALF + wr * 64 + m * 16 + fr;
                bf16_t* rp = O + (size_t)row * ldo + tok0;
#pragma unroll
                for (int bj = 0; bj < 2; ++bj)
#pragma unroll
                    for (int n = 0; n < 2; ++n) store8(rp + bj * HALF + n * 16, pack4(acc[ai][bj][m][n]));
            }
    }
};

struct EpiQUp {
    static constexpr bool PERM = false, AFTER_DRAIN = false, INIT = false;
    bf16_t* Qa; const float* ssq_q; const float* gq; const float* ropeA; float qscale;
    __device__ __forceinline__ void operator()(const f32x4 (&acc)[2][2][4][2], const Unit& u, int wr, int wc, int fr, int fq) const {
        asm volatile("" : "+v"(fr), "+v"(fq));
        const int ws = 4 * u.pn + wc;
#pragma unroll
        for (int ai = 0; ai < 2; ++ai)
#pragma unroll
            for (int m = 0; m < 4; ++m) {
                const int row = u.pm * BM + ai * HALF + wr * 64 + m * 16 + fr;
                float sq = 0.f; if (fq < 3) { const f32x2 qa = *(const f32x2*)(ssq_q + (size_t)row * 8 + 2 * fq); sq = qa[0] + qa[1]; }
                const float rstd_a = rsqrtf(red_fq(sq) * (1.f / 384.f) + EPSN);
                if (ws < 8) {
                    float ss = 0.f;
#pragma unroll
                    for (int bj = 0; bj < 2; ++bj)
#pragma unroll
                        for (int n = 0; n < 2; ++n) ss += dot4(acc[ai][bj][m][n] * rstd_a);
                    ss = red_fq(ss);
                    const float r2 = rsqrtf(ss * (1.f / 64.f) + EPSN) * qscale * rstd_a;
                    bf16_t* dst = Qa + (size_t)row * 768 + ws * 96;
#pragma unroll
                    for (int bj = 0; bj < 2; ++bj)
#pragma unroll
                        for (int n = 0; n < 2; ++n) { const int d0 = 32 * bj + 16 * n + 4 * fq; const f32x4 g = *(const f32x4*)(gq + d0); store8(dst + d0, pack4(acc[ai][bj][m][n] * g * r2)); }
                } else {
                    const int s = row & (SEQ - 1);
                    const f32x4 g0 = *(const f32x4*)(gq + 64 + 4 * fq), g1 = *(const f32x4*)(gq + 80 + 4 * fq);
                    const f32x4 r0 = *(const f32x4*)(ropeA + (size_t)(s * 16 + 4 * fq) * 2), r1 = *(const f32x4*)(ropeA + (size_t)(s * 16 + 4 * fq) * 2 + 4);
                    const float cs[4] = {r0[0], r0[2], r1[0], r1[2]}, sn[4] = {r0[1], r0[3], r1[1], r1[3]};
#pragma unroll
                    for (int bj = 0; bj < 2; ++bj) {
                        const int h = 2 * (ws - 8) + bj;
                        const f32x4 v0 = acc[ai][bj][m][0] * rstd_a, v1 = acc[ai][bj][m][1] * rstd_a;
                        const float ss = red_fq(dot4(v0) + dot4(v1));
                        const float r2 = rsqrtf(ss * (1.f / 32.f) + EPSN);
                        f32x4 o1, o2;
#pragma unroll
                        for (int j = 0; j < 4; ++j) { const float x1 = v0[j] * r2 * g0[j], x2 = v1[j] * r2 * g1[j]; o1[j] = (x1 * cs[j] - x2 * sn[j]) * qscale; o2[j] = (x2 * cs[j] + x1 * sn[j]) * qscale; }
                        bf16_t* dst = Qa + (size_t)row * 768 + h * 96 + 64 + 4 * fq;
                        store8(dst, pack4(o1)); store8(dst + 16, pack4(o2));
                    }
                }
                if (m & 1) asm volatile("" ::: "memory");
            }
    }
};

struct EpiKUp {
    static constexpr bool PERM = false, AFTER_DRAIN = false, INIT = false;
    bf16_t* Ka; const float* gk;
    __device__ __forceinline__ void operator()(const f32x4 (&acc)[2][2][4][2], const Unit& u, int wr, int wc, int fr, int fq) const {
        asm volatile("" : "+v"(fr), "+v"(fq));
        const int h = 4 * u.pn + wc;
#pragma unroll
        for (int ai = 0; ai < 2; ++ai)
#pragma unroll
            for (int m = 0; m < 4; ++m) {
                const int row = u.pm * BM + ai * HALF + wr * 64 + m * 16 + fr;
                float ss = 0.f;
#pragma unroll
                for (int bj = 0; bj < 2; ++bj)
#pragma unroll
                    for (int n = 0; n < 2; ++n) ss += dot4(acc[ai][bj][m][n]);
                ss = red_fq(ss);
                const float r2 = rsqrtf(ss * (1.f / 64.f) + EPSN);
                bf16_t* dst = Ka + (size_t)row * 512 + h * 64;
#pragma unroll
                for (int bj = 0; bj < 2; ++bj)
#pragma unroll
                    for (int n = 0; n < 2; ++n) { const int d0 = 32 * bj + 16 * n + 4 * fq; const f32x4 g = *(const f32x4*)(gk + d0); store8(dst + d0, pack4(acc[ai][bj][m][n] * g * r2)); }
            }
    }
};

struct EpiWOut {
    static constexpr bool PERM = false, AFTER_DRAIN = false, INIT = true;
    const float* x; float* out; bf16_t* X1b; float* ssq_x1; f32x4 (&pre)[2][2][4][2]; bool use_pre;
    __device__ __forceinline__ void init_next(f32x4 (&acc)[2][2][4][2], const Unit& u, int wr, int wc, int fr, int fq) const {
        const int col0 = u.pn * BM + wc * 32 + 4 * fq;
#pragma unroll
        for (int ai = 0; ai < 2; ++ai)
#pragma unroll
            for (int m = 0; m < 4; ++m) {
                const size_t off = (size_t)(u.pm * BM + ai * HALF + wr * 64 + m * 16 + fr) * DM + col0;
#pragma unroll
                for (int bj = 0; bj < 2; ++bj)
#pragma unroll
                    for (int n = 0; n < 2; ++n) acc[ai][bj][m][n] = *(const f32x4*)(x + off + bj * HALF + n * 16);
            }
    }
    __device__ __forceinline__ void init(f32x4 (&acc)[2][2][4][2], const Unit& u, int wr, int wc, int fr, int fq) const {
        if (use_pre) {
#pragma unroll
            for (int a = 0; a < 2; ++a)
#pragma unroll
                for (int bb = 0; bb < 2; ++bb)
#pragma unroll
                    for (int m = 0; m < 4; ++m)
#pragma unroll
                        for (int n = 0; n < 2; ++n) acc[a][bb][m][n] = pre[a][bb][m][n];
            return;
        }
        const int col0 = u.pn * BM + wc * 32 + 4 * fq;
#pragma unroll
        for (int ai = 0; ai < 2; ++ai)
#pragma unroll
            for (int m = 0; m < 4; ++m) {
                const size_t off = (size_t)(u.pm * BM + ai * HALF + wr * 64 + m * 16 + fr) * DM + col0;
#pragma unroll
                for (int bj = 0; bj < 2; ++bj)
#pragma unroll
                    for (int n = 0; n < 2; ++n) acc[ai][bj][m][n] = *(const f32x4*)(x + off + bj * HALF + n * 16);
            }
    }
    __device__ __forceinline__ void operator()(const f32x4 (&acc)[2][2][4][2], const Unit& u, int wr, int wc, int fr, int fq) const {
        asm volatile("" : "+v"(fr), "+v"(fq));
        const int col0 = u.pn * BM + wc * 32 + 4 * fq;
#pragma unroll
        for (int ai = 0; ai < 2; ++ai)
#pragma unroll
            for (int m = 0; m < 4; ++m) {
                const int row = u.pm * BM + ai * HALF + wr * 64 + m * 16 + fr;
                const size_t off = (size_t)row * DM + col0;
                float ss = 0.f;
#pragma unroll
                for (int bj = 0; bj < 2; ++bj)
#pragma unroll
                    for (int n = 0; n < 2; ++n) {
                        const size_t o = off + bj * HALF + n * 16;
                        const f32x4 v = acc[ai][bj][m][n];
                        store8(X1b + o, pack4(v)); ss += dot4(v);
                    }
                ss = red_fq(ss);
                if (fq == 0) ssq_x1[(size_t)row * 16 + u.pn * 4 + wc] = ss;
            }
    }
};

struct EpiGateUp {
    static constexpr bool PERM = false, AFTER_DRAIN = false, INIT = false;
    bf16_t* A; float* HL; const float* ssq_x1; const float* conv_w; const float* conv_b;
    __device__ __forceinline__ void operator()(f32x4 (&acc)[2][2][4][2], const Unit& u, int wr, int wc, int fr, int fq) const {
        asm volatile("" : "+v"(fr), "+v"(fq));
        const int lane = fq * 16 + fr;
#pragma unroll
        for (int ai = 0; ai < 2; ++ai)
#pragma unroll
            for (int m = 0; m < 4; ++m) {
                const int row = u.pm * BM + ai * HALF + wr * 64 + m * 16 + fr;
                const f32x4 a = *(const f32x4*)(ssq_x1 + (size_t)row * 16 + 4 * fq);
                const float rs = rsqrtf(red_fq((a[0] + a[1]) + (a[2] + a[3])) * (1.f / 1024.f) + EPSN);
#pragma unroll
                for (int bj = 0; bj < 2; ++bj)
#pragma unroll
                    for (int n = 0; n < 2; ++n) acc[ai][bj][m][n] *= rs;
            }
#pragma unroll
        for (int n = 0; n < 2; ++n) {
            const int f = u.pn * 128 + wc * 32 + 16 * n + 4 * fq;
            const f32x4 w0 = *(const f32x4*)(conv_w + f), w1 = *(const f32x4*)(conv_w + FF + f), w2 = *(const f32x4*)(conv_w + 2 * FF + f), cb = *(const f32x4*)(conv_b + f);
#pragma unroll
            for (int ai = 0; ai < 2; ++ai) {
                f32x4 gprev = (f32x4){0.f, 0.f, 0.f, 0.f};
                const int kb = u.pm * 4 + ai * 2 + wr;
#pragma unroll
                for (int m = 0; m < 4; ++m) {
                    const int row = u.pm * BM + ai * HALF + wr * 64 + m * 16 + fr;
                    const f32x4 gc = acc[ai][0][m][n], uc = acc[ai][1][m][n];
                    f32x4 o;
#pragma unroll
                    for (int j = 0; j < 4; ++j) {
                        const float y1 = (fr == 15) ? gprev[j] : gc[j], y2 = (fr >= 14) ? gprev[j] : gc[j];
                        const float g1 = __builtin_bit_cast(float, __builtin_amdgcn_update_dpp(0, __builtin_bit_cast(int, y1), 0x121, 0xF, 0xF, false));
                        const float g2 = __builtin_bit_cast(float, __builtin_amdgcn_update_dpp(0, __builtin_bit_cast(int, y2), 0x122, 0xF, 0xF, false));
                        const float cv = w2[j] * gc[j] + w1[j] * g1 + w0[j] * g2 + cb[j];
                        o[j] = cv * __builtin_amdgcn_rcpf(1.f + __expf(-cv)) * uc[j];
                    }
                    if (m != 0 || fr >= 2) store8(A + (size_t)row * FF + f, pack4(o));
                    if (m == 0 && fr < 2) { *(f32x4*)(HL + ((size_t)kb * 6 + 2 + fr) * FF + f) = gc; *(f32x4*)(HL + ((size_t)kb * 6 + 4 + fr) * FF + f) = uc; }
                    if (m == 3 && fr >= 14) *(f32x4*)(HL + ((size_t)kb * 6 + (fr - 14)) * FF + f) = gc;
                    gprev = gc;
                }
            }
        }
    }
};

struct EpiDown {
    static constexpr bool PERM = false, AFTER_DRAIN = false, INIT = true;
    const bf16_t* src; float* out; u32x2 (&pre)[2][2][4][2]; bool use_pre;
    __device__ __forceinline__ void init_next(f32x4 (&acc)[2][2][4][2], const Unit& u, int wr, int wc, int fr, int fq) const { load_tile(acc, u, wr, wc, fr, fq); }
    __device__ __forceinline__ void init(f32x4 (&acc)[2][2][4][2], const Unit& u, int wr, int wc, int fr, int fq) const {
        if (use_pre) {
#pragma unroll
            for (int a = 0; a < 2; ++a)
#pragma unroll
                for (int bb = 0; bb < 2; ++bb)
#pragma unroll
                    for (int m = 0; m < 4; ++m)
#pragma unroll
                        for (int n = 0; n < 2; ++n) { const u32x2 w = pre[a][bb][m][n]; acc[a][bb][m][n] = (f32x4){__builtin_bit_cast(float, w.x << 16), __builtin_bit_cast(float, w.x & 0xffff0000u), __builtin_bit_cast(float, w.y << 16), __builtin_bit_cast(float, w.y & 0xffff0000u)}; }
            return;
        }
        load_tile(acc, u, wr, wc, fr, fq);
    }
    __device__ __forceinline__ void load_tile(f32x4 (&acc)[2][2][4][2], const Unit& u, int wr, int wc, int fr, int fq) const {
        const int col0 = u.pn * BM + wc * 32 + 4 * fq;
#pragma unroll
        for (int ai = 0; ai < 2; ++ai)
#pragma unroll
            for (int m = 0; m < 4; ++m) {
                const size_t off = (size_t)(u.pm * BM + ai * HALF + wr * 64 + m * 16 + fr) * DM + col0;
#pragma unroll
                for (int bj = 0; bj < 2; ++bj)
#pragma unroll
                    for (int n = 0; n < 2; ++n) { const u32x2 w = *(const u32x2*)(src + off + bj * HALF + n * 16); acc[ai][bj][m][n] = (f32x4){__builtin_bit_cast(float, w.x << 16), __builtin_bit_cast(float, w.x & 0xffff0000u), __builtin_bit_cast(float, w.y << 16), __builtin_bit_cast(float, w.y & 0xffff0000u)}; }
            }
    }
    __device__ __forceinline__ void operator()(const f32x4 (&acc)[2][2][4][2], const Unit& u, int wr, int wc, int fr, int fq) const {
        asm volatile("" : "+v"(fr), "+v"(fq));
        const int col0 = u.pn * BM + wc * 32 + 4 * fq;
#pragma unroll
        for (int ai = 0; ai < 2; ++ai)
#pragma unroll
            for (int m = 0; m < 4; ++m) {
                const size_t off = (size_t)(u.pm * BM + ai * HALF + wr * 64 + m * 16 + fr) * DM + col0;
#pragma unroll
                for (int bj = 0; bj < 2; ++bj)
#pragma unroll
                    for (int n = 0; n < 2; ++n) *(f32x4*)(out + off + bj * HALF + n * 16) = acc[ai][bj][m][n];
            }
    }
};

template <class Epi, class Sched, bool ALIGN_EPI = false, bool SP2 = false>
__device__ __forceinline__ void gemm_phase(PG8_LAS unsigned char* lds, const Gemm g, const Sched& S, const Epi& E, const int wave_s) {
    int tid_ = wave_s * 64 + lane_fresh(); asm volatile("" : "+v"(tid_));
    const int tid = tid_, wid = __builtin_amdgcn_readfirstlane(tid >> 6), lane = tid & 63, wr = wid >> 2, wc = wid & 3, fr = lane & 15, fq = lane >> 4;
    const int K = g.K, nt = K / BK;
    unsigned voffA[2], voffB[2];
#pragma unroll
    for (int i = 0; i < 2; ++i) { int R, C; stage_rc(tid * 16 + i * 8192, R, C); const int Rb = Epi::PERM ? ((R & ~31) + perm32(R & 31)) : R;
        voffA[i] = (unsigned)(R * K + C) * 2u; voffB[i] = (unsigned)(Rb * K + C) * 2u; }
    const size_t kstep = (size_t)(BK * 2);
    const size_t hstep = (size_t)HALF * K * 2;
    const size_t tstep = 2 * hstep;
    const unsigned ldsw = (unsigned)wid * 1024u;
    const int aoff = lds_byte(wr * 64 + fr, fq * 8), boff = lds_byte(wc * 32 + fr, fq * 8);
#define PG8_SA(b, h) (((b) * 2 + (h)) * HTB)
#define PG8_SB(b, h) ((4 + (b) * 2 + (h)) * HTB)
#define PG8_STAGE(bufoff, gbase, voff) do { _Pragma("unroll") for (int _i = 0; _i < 2; ++_i) \
        __builtin_amdgcn_global_load_lds((const unsigned*)((const char*)(gbase) + (voff)[_i]), (PG8_LAS unsigned*)(lds + (bufoff) + ldsw + _i * 8192), 16, 0, 0); } while (0)
#define PG8_LDA(dst, b, h) do { _Pragma("unroll") for (int m = 0; m < 4; ++m) _Pragma("unroll") for (int k = 0; k < 2; ++k) dst[m][k] = *(const PG8_LAS bf16x8*)(lds + PG8_SA(b, h) + aoff + m * 2048 + k * 1024); } while (0)
#define PG8_LDB(dst, b, h) do { _Pragma("unroll") for (int n = 0; n < 2; ++n) _Pragma("unroll") for (int k = 0; k < 2; ++k) dst[n][k] = *(const PG8_LAS bf16x8*)(lds + PG8_SB(b, h) + boff + n * 2048 + k * 1024); } while (0)
#define PG8_MMA(ai, bj, At, Bt) do { __builtin_amdgcn_s_setprio(1); _Pragma("unroll") for (int m = 0; m < 4; ++m) _Pragma("unroll") for (int n = 0; n < 2; ++n) _Pragma("unroll") for (int k = 0; k < 2; ++k) \
        acc[ai][bj][m][n] = __builtin_amdgcn_mfma_f32_16x16x32_bf16(Bt[n][k], At[m][k], acc[ai][bj][m][n], 0, 0, 0); __builtin_amdgcn_s_setprio(0); } while (0)
#define PG8_WAIT_V(n) asm volatile("s_waitcnt vmcnt(" #n ")" ::: "memory")
#define PG8_WAIT_L(n) asm volatile("s_waitcnt lgkmcnt(" #n ")" ::: "memory")
#define PG8_BAR __builtin_amdgcn_s_barrier()
#define PG8_SCHED __builtin_amdgcn_sched_barrier(0)
    Unit cur, nxt; int ui = 0;
    if (!S.next(0, cur)) return;
    f32x4 acc[2][2][4][2];
#pragma unroll
    for (int a = 0; a < 2; ++a)
#pragma unroll
        for (int b = 0; b < 2; ++b)
#pragma unroll
            for (int m = 0; m < 4; ++m)
#pragma unroll
                for (int n = 0; n < 2; ++n) acc[a][b][m][n] = (f32x4){0.f, 0.f, 0.f, 0.f};
    if constexpr (Epi::INIT) E.init(acc, cur, wr, wc, fr, fq);
    bf16x8 At[4][2], B0[2][2], B1[2][2];
    const char* cA = (const char*)g.A + (size_t)cur.pm * tstep; const char* cB = (const char*)g.Bt + (size_t)cur.pn * tstep;
    S.a_ready(cur);
    if constexpr (SP2) {
        PG8_STAGE(PG8_SB(0, 0), cB, voffB); PG8_STAGE(PG8_SB(0, 1), cB + hstep, voffB); PG8_STAGE(PG8_SA(0, 0), cA, voffA); PG8_STAGE(PG8_SA(0, 1), cA + hstep, voffA);
        if (wr == 1) PG8_BAR;
        PG8_WAIT_V(2); PG8_BAR;
        PG8_STAGE(PG8_SB(1, 0), cB + kstep, voffB); PG8_STAGE(PG8_SA(1, 0), cA + kstep, voffA); PG8_STAGE(PG8_SB(1, 1), cB + hstep + kstep, voffB);
        PG8_WAIT_V(6); PG8_BAR;
    } else {
        PG8_STAGE(PG8_SB(0, 0), cB, voffB); PG8_STAGE(PG8_SA(0, 0), cA, voffA); PG8_STAGE(PG8_SB(0, 1), cB + hstep, voffB); PG8_STAGE(PG8_SA(0, 1), cA + hstep, voffA);
        if (wr == 1) PG8_BAR;
        PG8_WAIT_V(4); PG8_BAR;
        PG8_STAGE(PG8_SB(1, 0), cB + kstep, voffB); PG8_STAGE(PG8_SA(1, 0), cA + kstep, voffA); PG8_STAGE(PG8_SB(1, 1), cB + hstep + kstep, voffB);
        PG8_WAIT_V(6); PG8_BAR;
    }
    for (;;) {
        const bool has_next = S.next(ui + 1, nxt);
        const char* nA = has_next ? (const char*)g.A + (size_t)nxt.pm * tstep : cA; const char* nB = has_next ? (const char*)g.Bt + (size_t)nxt.pn * tstep : cB;
        for (int t = 0; t < nt; t += 2) {
            const bool last = (t == nt - 2);
            const char* a1 = cA + (size_t)(t + 1) * kstep;
            const char* a2 = last ? nA : cA + (size_t)(t + 2) * kstep; const char* b2 = last ? nB : cB + (size_t)(t + 2) * kstep;
            const char* a3 = a2 + kstep; const char* b3 = b2 + kstep;
            if (last && has_next) S.a_ready(nxt);
            if constexpr (SP2) {
            PG8_LDB(B0, 0, 0); PG8_LDB(B1, 0, 1); PG8_SCHED; PG8_LDA(At, 0, 0); PG8_STAGE(PG8_SA(1, 1), a1 + hstep, voffA);
            PG8_WAIT_V(8); PG8_WAIT_L(0); PG8_BAR; PG8_MMA(0, 0, At, B0); PG8_MMA(0, 1, At, B1); PG8_BAR; PG8_SCHED;
            PG8_LDA(At, 0, 1); PG8_STAGE(PG8_SB(0, 0), b2, voffB); PG8_STAGE(PG8_SB(0, 1), b2 + hstep, voffB); PG8_STAGE(PG8_SA(0, 0), a2, voffA);
            PG8_WAIT_V(8); PG8_WAIT_L(0); PG8_BAR; PG8_MMA(1, 0, At, B0); PG8_MMA(1, 1, At, B1); PG8_BAR; PG8_SCHED;
            PG8_LDB(B0, 1, 0); PG8_LDB(B1, 1, 1); PG8_SCHED; PG8_LDA(At, 1, 0); PG8_STAGE(PG8_SA(0, 1), a2 + hstep, voffA);
            PG8_WAIT_V(8); PG8_WAIT_L(0); PG8_BAR; PG8_MMA(0, 0, At, B0); PG8_MMA(0, 1, At, B1); PG8_BAR; PG8_SCHED;
            PG8_LDA(At, 1, 1); PG8_STAGE(PG8_SB(1, 0), b3, voffB); PG8_STAGE(PG8_SB(1, 1), b3 + hstep, voffB); PG8_STAGE(PG8_SA(1, 0), a3, voffA);
            PG8_WAIT_V(8); PG8_WAIT_L(0); PG8_BAR; PG8_MMA(1, 0, At, B0); PG8_MMA(1, 1, At, B1); PG8_BAR; PG8_SCHED;
            } else {
            PG8_LDB(B0, 0, 0); PG8_SCHED; PG8_LDA(At, 0, 0); PG8_STAGE(PG8_SA(1, 1), a1 + hstep, voffA);
            PG8_WAIT_L(8); PG8_BAR; PG8_WAIT_L(0); PG8_MMA(0, 0, At, B0); PG8_BAR; PG8_SCHED;
            PG8_LDB(B1, 0, 1); PG8_STAGE(PG8_SB(0, 0), b2, voffB);
            PG8_BAR; PG8_WAIT_L(0); PG8_MMA(0, 1, At, B1); PG8_BAR;
            PG8_LDA(At, 0, 1); PG8_STAGE(PG8_SA(0, 0), a2, voffA);
            PG8_BAR; PG8_WAIT_L(0); PG8_MMA(1, 0, At, B0); PG8_BAR; PG8_SCHED;
            PG8_STAGE(PG8_SB(0, 1), b2 + hstep, voffB);
            PG8_WAIT_V(6); PG8_BAR; PG8_MMA(1, 1, At, B1); PG8_BAR;
            PG8_LDB(B0, 1, 0); PG8_SCHED; PG8_LDA(At, 1, 0); PG8_STAGE(PG8_SA(0, 1), a2 + hstep, voffA);
            PG8_WAIT_L(8); PG8_BAR; PG8_WAIT_L(0); PG8_MMA(0, 0, At, B0); PG8_BAR; PG8_SCHED;
            PG8_LDB(B1, 1, 1); PG8_STAGE(PG8_SB(1, 0), b3, voffB);
            PG8_BAR; PG8_WAIT_L(0); PG8_MMA(0, 1, At, B1); PG8_BAR;
            PG8_LDA(At, 1, 1); PG8_STAGE(PG8_SA(1, 0), a3, voffA);
            PG8_BAR; PG8_WAIT_L(0); PG8_MMA(1, 0, At, B0); PG8_BAR; PG8_SCHED;
            PG8_STAGE(PG8_SB(1, 1), b3 + hstep, voffB);
            PG8_WAIT_V(6); PG8_BAR; PG8_MMA(1, 1, At, B1); PG8_BAR;
            }
        }
        if constexpr (ALIGN_EPI) { if (wr == 0) PG8_BAR; }
        if constexpr (!Epi::AFTER_DRAIN) { E(acc, cur, wr, wc, fr, fq); S.done(cur); }
        if (!has_next) break;
#pragma unroll
        for (int a = 0; a < 2; ++a)
#pragma unroll
            for (int b = 0; b < 2; ++b)
#pragma unroll
                for (int m = 0; m < 4; ++m)
#pragma unroll
                    for (int n = 0; n < 2; ++n) acc[a][b][m][n] = (f32x4){0.f, 0.f, 0.f, 0.f};
        if constexpr (Epi::INIT) E.init_next(acc, nxt, wr, wc, fr, fq);
        cur = nxt; cA = nA; cB = nB; ++ui;
        if constexpr (ALIGN_EPI) { if (wr == 1) PG8_BAR; }
    }
    PG8_WAIT_V(0);
    if constexpr (!ALIGN_EPI) { if (wr == 0) PG8_BAR; }
    PG8_BAR;
    if constexpr (Epi::AFTER_DRAIN) { E.fused(acc, cur, wr, wc, fr, fq, lds, wid, lane); S.done(cur); }
#undef PG8_SA
#undef PG8_SB
#undef PG8_STAGE
#undef PG8_LDA
#undef PG8_LDB
#undef PG8_MMA
#undef PG8_WAIT_V
#undef PG8_WAIT_L
#undef PG8_BAR
#undef PG8_SCHED
}
}

#define LAS __attribute__((address_space(3)))
using pg8::bf16_t; using pg8::bf16x8; using pg8::f32x4; using pg8::u32x4; using pg8::u32x2;
typedef float f32x16 __attribute__((ext_vector_type(16)));
constexpr int NWAVES = 8, NTHR = 512;
constexpr int LDS_BYTES = 147456;

constexpr size_t MiB = 1u << 20;
constexpr size_t WS_ROPEA = 0, WS_ROPEB = 262144, WS_CTL = 800 * 1024, CTL_BYTES = 65536;
constexpr size_t WS_WIN = 1 * MiB;
constexpr size_t WS_WDV = WS_WIN + (size_t)1792 * 1024 * 2;
constexpr size_t WS_WQ = WS_WDV + (size_t)512 * 1024 * 2;
constexpr size_t WS_WK = WS_WQ + (size_t)768 * 384 * 2;
constexpr size_t WS_WV = WS_WK + (size_t)512 * 256 * 2;
constexpr size_t WS_WO = WS_WV + (size_t)512 * 256 * 2;
constexpr size_t WS_WGU = WS_WO + (size_t)1024 * 1024 * 2;
constexpr size_t WS_WD = WS_WGU + (size_t)5632 * 1024 * 2;
static_assert(WS_WD + (size_t)1024 * 2816 * 2 <= 26 * MiB, "weights");
constexpr size_t WS_SSQQ = 26 * MiB, WS_SSQKV = 26 * MiB + 524288, WS_SSQX = 27 * MiB;
constexpr size_t WS_H = 28 * MiB;
constexpr size_t WS_CQ = 60 * MiB, WS_CKV = 72 * MiB, WS_QA = 80 * MiB, WS_KA = 104 * MiB, WS_VTA = 128 * MiB;
constexpr size_t WS_ABUF = 60 * MiB;
constexpr size_t WS_QD = 148 * MiB, WS_KD = 164 * MiB, WS_VTD = 180 * MiB, WS_O = 196 * MiB, WS_HL = 228 * MiB;
static_assert(WS_ABUF + (size_t)M * FF * 2 <= WS_QD && WS_HL + (size_t)256 * 6 * FF * 4 <= 256 * MiB, "d_ws map");

struct Params {
    const float* in[23]; float* out; unsigned char* ws;
    float invA[16]; float invB[32];
    int ph_lo, ph_hi;
};

__device__ __forceinline__ float wave_sum(float v) {
#pragma unroll
    for (int o = 1; o < 64; o <<= 1) v += shx(v, o);
    return v;
}
__device__ __forceinline__ unsigned pk2(float lo, float hi) { return pg8::cvt_pk_bf16(lo, hi); }

__device__ __forceinline__ void p0_transpose_item(const float* W, int ldw, int K, bf16_t* WT, int drow0, const float* gain, LAS float* scr, int k0, int n0, int lane) {
    {
        const int kr = lane >> 3, nc = (lane & 7) * 4;
        const float* wp = W + (size_t)(k0 + kr) * ldw + n0 + nc;
        f32x4 wv[8];
#pragma unroll
        for (int i = 0; i < 8; ++i) wv[i] = *(const f32x4*)(wp + (size_t)(8 * i) * ldw);
        if (gain) {
#pragma unroll
            for (int i = 0; i < 8; ++i) wv[i] *= gain[k0 + 8 * i + kr];
        }
#pragma unroll
        for (int i = 0; i < 8; ++i) { LAS float* d = scr + (8 * i + kr) * 33 + nc; d[0] = wv[i][0]; d[1] = wv[i][1]; d[2] = wv[i][2]; d[3] = wv[i][3]; }
    }
    asm volatile("s_waitcnt lgkmcnt(0)" ::: "memory");
    const int c = lane & 7;
#pragma unroll
    for (int j = 0; j < 4; ++j) { const int n = (lane >> 3) + 8 * j; const LAS float* s = scr + (8 * c) * 33 + n;
        u32x4 o; o.x = pk2(s[0 * 33], s[1 * 33]); o.y = pk2(s[2 * 33], s[3 * 33]); o.z = pk2(s[4 * 33], s[5 * 33]); o.w = pk2(s[6 * 33], s[7 * 33]);
        *(u32x4*)(WT + (size_t)(drow0 + n) * K + k0 + 8 * c) = o; }
    asm volatile("s_waitcnt lgkmcnt(0)" ::: "memory");
}

__device__ __forceinline__ void convert_items(const Params& p, LAS unsigned char* lds, int it0, int it1, int gw, int NGW, int wave, int lane) {
    unsigned char* ws = p.ws;
    LAS float* scr = (LAS float*)(lds + wave * 16384);
    bf16_t* Win = (bf16_t*)(ws + WS_WIN); bf16_t* Wdv = (bf16_t*)(ws + WS_WDV); bf16_t* Wq = (bf16_t*)(ws + WS_WQ); bf16_t* Wk = (bf16_t*)(ws + WS_WK);
    bf16_t* Wv = (bf16_t*)(ws + WS_WV); bf16_t* Wo = (bf16_t*)(ws + WS_WO); bf16_t* Wgu = (bf16_t*)(ws + WS_WGU); bf16_t* Wd = (bf16_t*)(ws + WS_WD);
    constexpr int I_IN = 16 * 69, I_Q = 6 * 24, I_KV = 4 * 32, I_O = 16 * 32, I_G = 16 * 88, I_D = 44 * 32;
    constexpr int NITEMS = I_IN + I_Q + I_KV + I_O + 2 * I_G + I_D;
    for (int it = it0 + gw; it < it1; it += NGW) {
        int r = it;
        if (r < I_IN) { const int kb = r / 69, nb = r % 69, n0 = nb * 32;
            if (n0 < 1696) { const int L = (n0 < 384) ? n0 : (n0 < 640) ? 512 + (n0 - 384) : (n0 < 672) ? 384 + (n0 - 640) : (n0 < 1184) ? 768 + (n0 - 672) : 1280 + (n0 - 1184);
                const int T = L >> 8, l = L & 255, g = l >> 6, bj = (l >> 5) & 1;
                p0_transpose_item(p.in[2], 2208, 1024, Win, 256 * T + 128 * bj + 32 * g, nullptr, scr, kb * 64, n0, lane); }
            else p0_transpose_item(p.in[2], 2208, 1024, Wdv, n0 - 1696, nullptr, scr, kb * 64, n0, lane);
            continue; }
        r -= I_IN;
        if (r < I_Q) { const int kb = r / 24, nb = r % 24, n0 = nb * 32, h = n0 / 96, blk = (n0 % 96) / 32;
            const int wsl = (blk < 2) ? h : 8 + (h >> 1), bj = (blk < 2) ? blk : (h & 1);
            p0_transpose_item(p.in[4], 768, 384, Wq, 256 * (wsl >> 2) + 128 * bj + 32 * (wsl & 3), p.in[3], scr, kb * 64, n0, lane); continue; }
        r -= I_Q;
        if (r < I_KV) { const int kb = r / 32, nb = r % 32, n0 = nb * 32, h = n0 >> 7, c0 = n0 & 127;
            if (c0 < 64) p0_transpose_item(p.in[6], 1024, 256, Wk, 256 * (h >> 2) + 128 * (c0 >> 5) + 32 * (h & 3), p.in[5], scr, kb * 64, n0, lane);
            else p0_transpose_item(p.in[6], 1024, 256, Wv, h * 64 + (c0 - 64), p.in[5], scr, kb * 64, n0, lane);
            continue; }
        r -= I_KV;
        if (r < I_O) { const int kb = r / 32, nb = r % 32; p0_transpose_item(p.in[16], 1024, 1024, Wo, nb * 32, nullptr, scr, kb * 64, nb * 32, lane); continue; }
        r -= I_O;
        if (r < 2 * I_G) { const int up = r >= I_G; if (up) r -= I_G; const int kb = r / 88, nb = r % 88, f0 = nb * 32;
            p0_transpose_item(p.in[up ? 19 : 18], FF, 1024, Wgu, 256 * (f0 >> 7) + 128 * up + 32 * ((f0 >> 5) & 3), p.in[17], scr, kb * 64, f0, lane); continue; }
        r -= 2 * I_G;
        { const int kb = r / 32, nb = r % 32; p0_transpose_item(p.in[22], 1024, FF, Wd, nb * 32, nullptr, scr, kb * 64, nb * 32, lane); }
    }
}
constexpr int CONV_EARLY = 16 * 69 + 6 * 24 + 4 * 32, CONV_ALL = CONV_EARLY + 16 * 32 + 2 * 16 * 88 + 44 * 32;
__device__ __forceinline__ void p0_prologue(const Params& p, LAS unsigned char* lds, int vcu, int G, int wave, int lane) {
    unsigned char* ws = p.ws;
    const int gw = vcu * NWAVES + wave, NGW = G * NWAVES;
    bf16_t* Win = (bf16_t*)(ws + WS_WIN);
    for (int i = gw * 64 + lane; i < 96 * 128; i += NGW * 64) { const int rr = i >> 7, c = i & 127; const int row = 256 + (rr < 32 ? 352 - 256 + rr : 448 - 256 + (rr - 32)); *(u32x4*)(Win + (size_t)row * 1024 + c * 8) = (u32x4){0u, 0u, 0u, 0u}; }
    float* ropeA = (float*)(ws + WS_ROPEA); float* ropeB = (float*)(ws + WS_ROPEB);
    for (int i = gw * 64 + lane; i < SEQ * 48; i += NGW * 64) {
        const bool isA = i < SEQ * 16; const int e = isA ? i : i - SEQ * 16; const int s = isA ? e >> 4 : e >> 5, k = isA ? e & 15 : e & 31;
        const float ang = (float)s * (isA ? p.invA[k] : p.invB[k]);
        const double rev = (double)ang * 0.15915494309189535; const float fr = (float)(rev - floor(rev));
        const float sn = __builtin_amdgcn_sinf(fr), cs = __builtin_amdgcn_cosf(fr);
        float* dst = (isA ? ropeA : ropeB) + (size_t)e * 2; dst[0] = cs; dst[1] = sn;
    }
    bf16_t* H = (bf16_t*)(ws + WS_H); const float* x = p.in[0]; const float* g = p.in[1];
    f32x4 gv[4];
#pragma unroll
    for (int j = 0; j < 4; ++j) gv[j] = *(const f32x4*)(g + 4 * lane + 256 * j);
    for (int m0 = gw; m0 < M; m0 += 4 * NGW) {
        f32x4 v[4][4]; float s[4];
#pragma unroll
        for (int q = 0; q < 4; ++q) { const int m = m0 + q * NGW; const f32x4* xr = (const f32x4*)(x + (size_t)(m < M ? m : m0) * DM) + lane;
#pragma unroll
            for (int j = 0; j < 4; ++j) v[q][j] = __builtin_nontemporal_load(xr + 64 * j); }
#pragma unroll
        for (int q = 0; q < 4; ++q) { s[q] = 0.f;
#pragma unroll
            for (int j = 0; j < 4; ++j) s[q] += pg8::dot4(v[q][j]); }
#pragma unroll
        for (int o = 1; o < 64; o <<= 1) { const int idx = (lane_fresh() ^ o) << 2;
#pragma unroll
            for (int q = 0; q < 4; ++q) s[q] += __builtin_bit_cast(float, __builtin_amdgcn_ds_bpermute(idx, __builtin_bit_cast(int, s[q]))); }
#pragma unroll
        for (int q = 0; q < 4; ++q) { const int m = m0 + q * NGW; if (m < M) {
            const float rstd = rsqrtf(s[q] * (1.f / DM) + EPS);
            unsigned long long* o8 = (unsigned long long*)(H + (size_t)m * DM) + lane;
#pragma unroll
            for (int j = 0; j < 4; ++j) { const f32x4 y = v[q][j] * gv[j] * rstd; __builtin_nontemporal_store((unsigned long long)pk2(y[0], y[1]) | ((unsigned long long)pk2(y[2], y[3]) << 32), o8 + 64 * j); } } }
    }
    convert_items(p, lds, 0, CONV_EARLY, gw, NGW, wave, lane);
}

struct AttnP { const bf16_t *Qa, *Kn, *Kpe, *Vta, *Qd, *Kd, *Vtd; bf16_t* O; const float* subln_g; };
__device__ __forceinline__ bf16x8 packp(const f32x16& p, int b) {
    u32x4 w; w.x = pk2(p[b], p[b + 1]); w.y = pk2(p[b + 2], p[b + 3]); w.z = pk2(p[b + 4], p[b + 5]); w.w = pk2(p[b + 6], p[b + 7]);
    return __builtin_bit_cast(bf16x8, w);
}
template <bool DIFF> __device__ __forceinline__ void attn_unit(LAS unsigned char* lds, const AttnP& P, int b, int h, int qb, float lam, const int wave_s, const int VAR = 0) {
    constexpr int DQK = DIFF ? 64 : 96, DV = DIFF ? 128 : 64, QROWS = DIFF ? 128 : 256, NDB = DV / 32, NS = DQK / 16;
    constexpr int STAGE = DIFF ? 32768 : 20480, V_OFF = DIFF ? 16384 : 12288, NSLOT = 4;
    static_assert(NSLOT * STAGE <= 131072 && 4 * 128 * 32 * 4 <= NSLOT * STAGE + 32768, "attention LDS");
    int tid_ = wave_s * 64 + lane_fresh(); asm volatile("" : "+v"(tid_));
    const int tid = tid_, lane = tid & 63, wid = __builtin_amdgcn_readfirstlane(tid >> 6), r32 = lane & 31, hi = lane >> 5;
    const int map = DIFF ? (wid >> 2) : 0, wq = DIFF ? (wid & 3) : wid;
    const int q0 = qb * QROWS, qw_min = q0 + 32 * wq, qrow = qw_min + r32;
    const size_t mrow0 = (size_t)b * SEQ;
    const bf16_t* Qp = DIFF ? P.Qd + (mrow0 + qrow) * 512 + h * 128 + map * 64 : P.Qa + (mrow0 + qrow) * 768 + h * 96;
    bf16x8 qf[NS];
#pragma unroll
    for (int s = 0; s < NS; ++s) qf[s] = *(const bf16x8*)(Qp + 16 * s + 8 * hi);
    const int NT = (VAR & 16) ? 2 : (q0 + QROWS) / 64, tl = (qw_min + 31) >> 6;
    const char* src[4]; int dsto[4]; int strd[4]; int nops;
    if (DIFF) {
        nops = 4;
#pragma unroll
        for (int i = 0; i < 2; ++i) { const int j = wid + 8 * i, row = 4 * j + (lane >> 4), c = (lane & 15) ^ (row & 15);
            src[i] = (const char*)(P.Kd + (mrow0 + row) * 512 + h * 128 + c * 8); dsto[i] = j * 1024; strd[i] = 65536; }
#pragma unroll
        for (int i = 0; i < 2; ++i) { const int j = wid + 8 * i, d = 8 * j + (lane >> 3), c = (lane & 7) ^ ((d >> 1) & 7);
            src[2 + i] = (const char*)(P.Vtd + (size_t)(h * 128 + d) * M + mrow0 + c * 8); dsto[2 + i] = V_OFF + j * 1024; strd[2 + i] = 128; }
    } else {
        nops = wid < 4 ? 3 : 2;
        { const int row = 8 * wid + (lane >> 3), c = (lane & 7) ^ ((row >> 1) & 7);
          src[0] = (const char*)(P.Kn + (mrow0 + row) * 512 + h * 64 + c * 8); dsto[0] = wid * 1024; strd[0] = 65536; }
        const int jv1 = wid < 4 ? wid + 4 : wid - 4;
        const int dv_ = 8 * jv1 + (lane >> 3), cv_ = (lane & 7) ^ ((dv_ >> 1) & 7);
        const char* vsrc = (const char*)(P.Vta + (size_t)(h * 64 + dv_) * M + mrow0 + cv_ * 8);
        const int prow = 16 * (wid & 3) + (lane >> 2), pc = (lane & 3) ^ ((prow >> 2) & 3);
        const char* psrc = (const char*)(P.Kpe + (mrow0 + prow) * 32 + pc * 8);
        if (wid < 4) { src[1] = psrc; dsto[1] = 8192 + wid * 1024; strd[1] = 4096; src[2] = vsrc; dsto[2] = V_OFF + jv1 * 1024; strd[2] = 128; }
        else { src[1] = vsrc; dsto[1] = V_OFF + jv1 * 1024; strd[1] = 128; src[2] = vsrc; dsto[2] = 0; strd[2] = 0; }
        src[3] = vsrc; dsto[3] = 0; strd[3] = 0;
    }
#define ATT_DMA(t, slot) do { if (!(VAR & 1)) _Pragma("unroll") for (int i_ = 0; i_ < 4; ++i_) if (i_ < nops) \
        __builtin_amdgcn_global_load_lds((const unsigned*)(src[i_] + (size_t)(t) * strd[i_]), (LAS unsigned*)(lds + (slot) * STAGE + dsto[i_]), 16, 0, 0); } while (0)
    const int x16 = r32 & 15, pi = (r32 & 16) + ((x16 < 4 || x16 >= 12) ? x16 : (x16 < 8 ? x16 + 4 : x16 - 4));
    int kaddr[NS], vaddr[4];
#pragma unroll
    for (int s = 0; s < NS; ++s) {
        if (DIFF) kaddr[s] = pi * 256 + (((8 * map + 2 * s + hi) ^ (pi & 15)) << 4);
        else if (s < 4) kaddr[s] = pi * 128 + (((2 * s + hi) ^ ((pi >> 1) & 7)) << 4);
        else kaddr[s] = 8192 + pi * 64 + (((2 * (s - 4) + hi) ^ ((pi >> 2) & 3)) << 4);
    }
#pragma unroll
    for (int a = 0; a < 4; ++a) vaddr[a] = V_OFF + r32 * 128 + (((2 * a + hi) ^ ((r32 >> 1) & 7)) << 4);
    f32x16 o[NDB];
#pragma unroll
    for (int d = 0; d < NDB; ++d)
#pragma unroll
        for (int r = 0; r < 16; ++r) o[d][r] = 0.f;
    float mref = 0.f, lsum = 0.f;
    f32x16 negm;
#pragma unroll
    for (int r = 0; r < 16; ++r) negm[r] = 0.f;
    __builtin_amdgcn_s_waitcnt(0);
    ATT_DMA(0, 0); ATT_DMA(1, 1);
#define SBAR() __builtin_amdgcn_sched_barrier(0)
#define MX3(a, b, c) __builtin_fmaxf(__builtin_fmaxf((a), (b)), (c))
#define ATT_WAIT(t) do { if (VAR & 1) {} else if ((t) + 1 < NT) { if (DIFF) asm volatile("s_waitcnt vmcnt(4)" ::: "memory"); else if (wid < 4) asm volatile("s_waitcnt vmcnt(3)" ::: "memory"); else asm volatile("s_waitcnt vmcnt(2)" ::: "memory"); } \
        else asm volatile("s_waitcnt vmcnt(0)" ::: "memory"); if (!(VAR & 4)) __builtin_amdgcn_s_barrier(); asm volatile("" ::: "memory"); } while (0)
#define ATT_QK(P0, P1, kb) do { _Pragma("unroll") for (int s = 0; s < NS; ++s) { const int pbo = DIFF ? 8192 : (s < 4 ? 4096 : 2048); \
            const bf16x8 k0 = *(const LAS bf16x8*)((kb) + kaddr[s]), k1 = *(const LAS bf16x8*)((kb) + kaddr[s] + pbo); \
            if (s == 0) { if (DIFF) { f32x16 z; _Pragma("unroll") for (int r = 0; r < 16; ++r) z[r] = 0.f; P0 = __builtin_amdgcn_mfma_f32_32x32x16_bf16(k0, qf[0], z, 0, 0, 0); P1 = __builtin_amdgcn_mfma_f32_32x32x16_bf16(k1, qf[0], z, 0, 0, 0); } \
                          else { P0 = __builtin_amdgcn_mfma_f32_32x32x16_bf16(k0, qf[0], negm, 0, 0, 0); P1 = __builtin_amdgcn_mfma_f32_32x32x16_bf16(k1, qf[0], negm, 0, 0, 0); } } \
            else { P0 = __builtin_amdgcn_mfma_f32_32x32x16_bf16(k0, qf[s], P0, 0, 0, 0); P1 = __builtin_amdgcn_mfma_f32_32x32x16_bf16(k1, qf[s], P1, 0, 0, 0); } } } while (0)
#define ATT_MASK(P0, P1, t) do { if (64 * (t) + 63 > qw_min) { const int kv0 = 64 * (t) + 8 * hi; \
            _Pragma("unroll") for (int r = 0; r < 16; ++r) { const int kv = kv0 + 16 * (r >> 3) + (r & 7); if (kv > qrow) P0[r] = -INFINITY; if (kv + 32 > qrow) P1[r] = -INFINITY; } } } while (0)
#define ATT_ROWMAX(rm, P0, P1) do { float ma = MX3(P0[0], P0[1], P1[0]), mb = MX3(P0[2], P0[3], P1[1]); ma = MX3(ma, P1[2], P1[3]); \
            _Pragma("unroll") for (int r = 4; r < 16; r += 4) { ma = MX3(ma, P0[r], P0[r + 1]); mb = MX3(mb, P0[r + 2], P0[r + 3]); ma = MX3(ma, P1[r], P1[r + 1]); mb = MX3(mb, P1[r + 2], P1[r + 3]); } \
            rm = fmaxf(ma, mb); rm = fmaxf(rm, shx(rm, 32)); } while (0)
#define ATT_SUB(P0, P1, v) do { const pg8::f32x2 m2_ = {(v), (v)}; _Pragma("unroll") for (int r = 0; r < 16; r += 2) { pg8::f32x2 a_ = {P0[r], P0[r + 1]}, b_ = {P1[r], P1[r + 1]}; a_ -= m2_; b_ -= m2_; P0[r] = a_[0]; P0[r + 1] = a_[1]; P1[r] = b_[0]; P1[r + 1] = b_[1]; } } while (0)
#define ATT_EXP(P0, P1) do { if (!(VAR & 2)) _Pragma("unroll") for (int r = 0; r < 16; ++r) { P0[r] = __builtin_amdgcn_exp2f(P0[r]); P1[r] = __builtin_amdgcn_exp2f(P1[r]); } } while (0)
#define ATT_SUMPACK(P0, P1) do { pg8::f32x2 s2 = {0.f, 0.f}; _Pragma("unroll") for (int r = 0; r < 16; r += 2) { s2 += (pg8::f32x2){P0[r], P0[r + 1]}; s2 += (pg8::f32x2){P1[r], P1[r + 1]}; } lsum += s2[0] + s2[1]; \
            pk[0] = packp(P0, 0); pk[1] = packp(P0, 8); pk[2] = packp(P1, 0); pk[3] = packp(P1, 8); } while (0)
#define ATT_PV(kb) do { if (!(VAR & 8)) _Pragma("unroll") for (int d = 0; d < NDB; ++d) _Pragma("unroll") for (int a = 0; a < 4; ++a) { \
            const bf16x8 vf = *(const LAS bf16x8*)((kb) + vaddr[a] + d * 4096); o[d] = __builtin_amdgcn_mfma_f32_32x32x16_bf16(vf, pk[a], o[d], 0, 0, 0); } } while (0)
    f32x16 pa0, pa1, pb0, pb1; bf16x8 pk[4];
    ATT_WAIT(0);
    if (2 < NT) ATT_DMA(2, 2);
    { ATT_QK(pa0, pa1, lds); ATT_MASK(pa0, pa1, 0); float rm; ATT_ROWMAX(rm, pa0, pa1); mref = rm; ATT_SUB(pa0, pa1, rm);
      if (!DIFF) { _Pragma("unroll") for (int r = 0; r < 16; ++r) negm[r] = -mref; }
      ATT_EXP(pa0, pa1); }
    float fpend = 1.f; bool rpend = false;
    for (int t = 1; t < NT; ++t) {
        ATT_WAIT(t);
        if (t + 2 < NT) ATT_DMA(t + 2, (t + 2) & 3);
        const LAS unsigned char* kc = lds + (t & 3) * STAGE; const LAS unsigned char* kp = lds + ((t - 1) & 3) * STAGE;
        if (rpend) {
#pragma unroll
            for (int d = 0; d < NDB; ++d)
#pragma unroll
                for (int r = 0; r < 16; ++r) o[d][r] *= fpend;
        }
        const bool live = t <= tl, plive = t - 1 <= tl;
        SBAR();
        if (live) { __builtin_amdgcn_s_setprio(1); ATT_QK(pb0, pb1, kc); __builtin_amdgcn_s_setprio(0); }
        if (plive) ATT_SUMPACK(pa0, pa1);
        SBAR();
        float f = 1.f; bool resc = false;
        if (live) {
            ATT_MASK(pb0, pb1, t);
            float rm; ATT_ROWMAX(rm, pb0, pb1);
            if (DIFF) { const float rel = rm - mref; resc = __any(rel > 8.0f); if (resc) { const float dl = fmaxf(rel, 0.f); f = __builtin_amdgcn_exp2f(-dl); mref += dl; lsum *= f; } ATT_SUB(pb0, pb1, mref); }
            else { resc = __any(rm > 8.0f); if (resc) { const float dl = fmaxf(rm, 0.f); f = __builtin_amdgcn_exp2f(-dl); mref += dl; lsum *= f; ATT_SUB(pb0, pb1, dl); _Pragma("unroll") for (int r = 0; r < 16; ++r) negm[r] = -mref; } }
        }
        SBAR();
        if (plive) { __builtin_amdgcn_s_setprio(1); ATT_PV(kp); __builtin_amdgcn_s_setprio(0); }
        if (live) ATT_EXP(pb0, pb1);
        SBAR();
        rpend = resc; fpend = f;
        pa0 = pb0; pa1 = pb1;
    }
    if (rpend) {
#pragma unroll
        for (int d = 0; d < NDB; ++d)
#pragma unroll
            for (int r = 0; r < 16; ++r) o[d][r] *= fpend;
    }
    if (NT - 1 <= tl) { ATT_SUMPACK(pa0, pa1); ATT_PV(lds + ((NT - 1) & 3) * STAGE); }
#undef ATT_DMA
#undef ATT_WAIT
#undef ATT_QK
#undef ATT_MASK
#undef ATT_ROWMAX
#undef ATT_SUB
#undef ATT_EXP
#undef ATT_SUMPACK
#undef ATT_PV
#undef MX3
#undef SBAR
    asm volatile("s_waitcnt lgkmcnt(0)" ::: "memory"); __builtin_amdgcn_s_barrier(); asm volatile("" ::: "memory");
    const float inv = 1.f / (lsum + shx(lsum, 32));
    if (!DIFF) {
        bf16_t* Op = P.O + (mrow0 + qrow) * 1024 + h * 64;
#pragma unroll
        for (int d = 0; d < NDB; ++d)
#pragma unroll
            for (int g = 0; g < 4; ++g) {
                u32x2 w; w.x = pk2(o[d][4 * g] * inv, o[d][4 * g + 1] * inv); w.y = pk2(o[d][4 * g + 2] * inv, o[d][4 * g + 3] * inv);
                *(u32x2*)(Op + 32 * d + 8 * g + 4 * hi) = w;
            }
    } else {
        LAS float* X = (LAS float*)lds;
        if (map == 1) {
#pragma unroll
            for (int d = 0; d < NDB; ++d)
#pragma unroll
                for (int r = 0; r < 16; ++r) { const int dd = 32 * d + (r & 3) + 8 * (r >> 2) + 4 * hi; X[(wq * 128 + dd) * 32 + r32] = o[d][r] * inv; }
        }
        asm volatile("s_waitcnt lgkmcnt(0)" ::: "memory"); __builtin_amdgcn_s_barrier(); asm volatile("" ::: "memory");
        if (map == 0) {
            float ss = 0.f;
#pragma unroll
            for (int d = 0; d < NDB; ++d)
#pragma unroll
                for (int r = 0; r < 16; ++r) { const int dd = 32 * d + (r & 3) + 8 * (r >> 2) + 4 * hi; const float v = o[d][r] * inv - lam * X[(wq * 128 + dd) * 32 + r32]; o[d][r] = v; ss += v * v; }
            ss += shx(ss, 32);
            const float rs = rsqrtf(ss * (1.f / 128.f) + EPS) * 0.8f;
            bf16_t* Op = P.O + (mrow0 + qrow) * 1024 + 512 + h * 128;
#pragma unroll
            for (int d = 0; d < NDB; ++d)
#pragma unroll
                for (int g = 0; g < 4; ++g) {
                    const int dd = 32 * d + 8 * g + 4 * hi; const f32x4 sg = *(const f32x4*)(P.subln_g + dd);
                    u32x2 w; w.x = pk2(o[d][4 * g] * rs * sg[0], o[d][4 * g + 1] * rs * sg[1]); w.y = pk2(o[d][4 * g + 2] * rs * sg[2], o[d][4 * g + 3] * rs * sg[3]);
                    *(u32x2*)(Op + dd) = w;
                }
        }
        asm volatile("s_waitcnt lgkmcnt(0)" ::: "memory"); __builtin_amdgcn_s_barrier(); asm volatile("" ::: "memory");
    }
}

#ifndef REP0
#define REP0 1
#endif
#ifndef REP1
#define REP1 1
#endif
#ifndef REP2
#define REP2 1
#endif
#ifndef REP3
#define REP3 1
#endif
#ifndef REP4
#define REP4 1
#endif
#ifndef REP5
#define REP5 1
#endif
#ifndef SKIP0
#define SKIP0 0
#endif
#ifndef SKIP1
#define SKIP1 0
#endif
#ifndef SKIP2
#define SKIP2 0
#endif
#ifndef SKIP3
#define SKIP3 0
#endif
#ifndef SKIP4
#define SKIP4 0
#endif
#ifndef SKIP5
#define SKIP5 0
#endif
#ifndef SKIP6
#define SKIP6 0
#endif
#ifndef SKIP7
#define SKIP7 0
#endif
#define XB_TMO      128
#define XB_XCNT(j)  (256  + 64 * (j))
#define XB_XSUB(j)  (1280 + 64 * (j))
#define XB_XGEN(j)  (2304 + 64 * (j))
#define XB_TOP      3328
#define XB_TOPGEN   3392
#define XCD_BAR_WORDS 3456
#define XB_SPIN_CAP (1u << 18)

__device__ __forceinline__ unsigned xb_ld(unsigned* p)              { return __hip_atomic_load(p, __ATOMIC_RELAXED, __HIP_MEMORY_SCOPE_AGENT); }
__device__ __forceinline__ unsigned xb_add(unsigned* p, unsigned v) { return __hip_atomic_fetch_add(p, v, __ATOMIC_RELAXED, __HIP_MEMORY_SCOPE_AGENT); }
__device__ __forceinline__ unsigned xb_xcc_id() { return (unsigned)__builtin_amdgcn_s_getreg((3 << 11) | 20) & 0xFu; }
#define XB_SPIN(cond, bar) do { unsigned _sp = 0; while (cond) { __builtin_amdgcn_s_sleep(1); \
    if ((++_sp & 255u) == 0u) { if (xb_ld(&(bar)[XB_TMO])) break; if (_sp > XB_SPIN_CAP) { atomicAdd(&(bar)[XB_TMO], 1u); break; } } } } while (0)

struct XcdBarrier {
    unsigned* bar; unsigned x;
    volatile LAS unsigned* st;
};

__device__ __forceinline__ XcdBarrier xcd_barrier_post(unsigned* bar, volatile LAS unsigned* st, bool t0) {
    XcdBarrier b; b.bar = bar; b.x = xb_xcc_id(); b.st = st;
    if (t0) (void)xb_add(&bar[XB_XCNT(b.x)], 1u);
    return b;
}
__device__ __forceinline__ void xcd_barrier_complete(unsigned* bar, unsigned x, unsigned& nloc, unsigned& nx) {
    const unsigned G = gridDim.x * gridDim.y * gridDim.z;
    unsigned sum, cnt, mine, sp = 0u;
    for (;;) {
        sum = 0u; cnt = 0u; mine = 0u;
#pragma unroll
        for (unsigned j = 0; j < 16; ++j) { const unsigned c = xb_ld(&bar[XB_XCNT(j)]); sum += c; cnt += (c > 0u) ? 1u : 0u; mine = (j == x) ? c : mine; }
        if (sum == G) break;
        __builtin_amdgcn_s_sleep(1);
        if ((++sp & 255u) == 0u) { if (xb_ld(&bar[XB_TMO])) break; if (sp > XB_SPIN_CAP) { atomicAdd(&bar[XB_TMO], 1u); break; } }
    }
    nloc = mine > 0u ? mine : 1u; nx = cnt > 0u ? cnt : 1u;
}

__device__ __forceinline__ void xcd_barrier(const XcdBarrier& b, bool t0) {
    asm volatile("s_waitcnt vmcnt(0)" ::: "memory");
    __syncthreads();
    if (t0) {
        unsigned* bar = b.bar;
        __builtin_amdgcn_s_waitcnt(0);
        unsigned nloc = b.st[0], nx = b.st[1];
        if (nloc == 0u) { xcd_barrier_complete(bar, b.x, nloc, nx); b.st[0] = nloc; b.st[1] = nx; }
        const unsigned old = xb_add(&bar[XB_XSUB(b.x)], 1u);
        const unsigned gen = old / nloc;
        if (old + 1u == (gen + 1u) * nloc) {
            __builtin_amdgcn_fence(__ATOMIC_RELEASE, "agent");
            asm volatile("s_waitcnt vmcnt(0)" ::: "memory");
            const unsigned og = xb_add(&bar[XB_TOP], 1u);
            const unsigned tg = og / nx;
            if (og + 1u == (tg + 1u) * nx) xb_add(&bar[XB_TOPGEN], 1u);
            else XB_SPIN(xb_ld(&bar[XB_TOPGEN]) == tg, bar);
            __builtin_amdgcn_fence(__ATOMIC_ACQUIRE, "agent");
            xb_add(&bar[XB_XGEN(b.x)], 1u);
            asm volatile("s_waitcnt vmcnt(0)" ::: "memory");
        } else {
            XB_SPIN(xb_ld(&bar[XB_XGEN(b.x)]) == gen, bar);
            __builtin_amdgcn_fence(__ATOMIC_ACQUIRE, "agent");
            asm volatile("s_waitcnt vmcnt(0)" ::: "memory");
        }
    }
    __syncthreads();
}

template <class F> __device__ __forceinline__ void xcd_barrier_preload(const XcdBarrier& b, bool t0, bool proto_wave, const F& hook) {
    asm volatile("s_waitcnt vmcnt(0)" ::: "memory");
    __syncthreads();
    if (!proto_wave) hook();
    if (t0) {
        unsigned* bar = b.bar;
        __builtin_amdgcn_s_waitcnt(0);
        unsigned nloc = b.st[0], nx = b.st[1];
        if (nloc == 0u) { xcd_barrier_complete(bar, b.x, nloc, nx); b.st[0] = nloc; b.st[1] = nx; }
        const unsigned old = xb_add(&bar[XB_XSUB(b.x)], 1u);
        const unsigned gen = old / nloc;
        if (old + 1u == (gen + 1u) * nloc) {
            __builtin_amdgcn_fence(__ATOMIC_RELEASE, "agent");
            asm volatile("s_waitcnt vmcnt(0)" ::: "memory");
            const unsigned og = xb_add(&bar[XB_TOP], 1u);
            const unsigned tg = og / nx;
            if (og + 1u == (tg + 1u) * nx) xb_add(&bar[XB_TOPGEN], 1u);
            else XB_SPIN(xb_ld(&bar[XB_TOPGEN]) == tg, bar);
            __builtin_amdgcn_fence(__ATOMIC_ACQUIRE, "agent");
            xb_add(&bar[XB_XGEN(b.x)], 1u);
            asm volatile("s_waitcnt vmcnt(0)" ::: "memory");
        } else {
            XB_SPIN(xb_ld(&bar[XB_XGEN(b.x)]) == gen, bar);
            __builtin_amdgcn_fence(__ATOMIC_ACQUIRE, "agent");
            asm volatile("s_waitcnt vmcnt(0)" ::: "memory");
        }
    }
    if (proto_wave) hook();
    __syncthreads();
}
struct PreloadX {
    const float* x; pg8::Unit u; int wave_s; pg8::f32x4 (&pre)[2][2][4][2];
    __device__ __forceinline__ void operator()() const {
        int tid_ = wave_s * 64 + lane_fresh(); asm volatile("" : "+v"(tid_));
        const int lane = tid_ & 63, wr = wave_s >> 2, wc = wave_s & 3, fr = lane & 15, fq = lane >> 4;
        const int col0 = u.pn * 256 + wc * 32 + 4 * fq;
#pragma unroll
        for (int ai = 0; ai < 2; ++ai)
#pragma unroll
            for (int m = 0; m < 4; ++m) {
                const size_t off = (size_t)(u.pm * 256 + ai * 128 + wr * 64 + m * 16 + fr) * DM + col0;
#pragma unroll
                for (int bj = 0; bj < 2; ++bj)
#pragma unroll
                    for (int n = 0; n < 2; ++n) pre[ai][bj][m][n] = *(const pg8::f32x4*)(x + off + bj * 128 + n * 16);
            }
    }
};
struct PreloadX1 {
    const bf16_t* x1; pg8::Unit u; int wave_s; pg8::u32x2 (&pre)[2][2][4][2];
    __device__ __forceinline__ void operator()() const {
        int tid_ = wave_s * 64 + lane_fresh(); asm volatile("" : "+v"(tid_));
        const int lane = tid_ & 63, wr = wave_s >> 2, wc = wave_s & 3, fr = lane & 15, fq = lane >> 4;
        const int col0 = u.pn * 256 + wc * 32 + 4 * fq;
#pragma unroll
        for (int ai = 0; ai < 2; ++ai)
#pragma unroll
            for (int m = 0; m < 4; ++m) {
                const size_t off = (size_t)(u.pm * 256 + ai * 128 + wr * 64 + m * 16 + fr) * DM + col0;
#pragma unroll
                for (int bj = 0; bj < 2; ++bj)
#pragma unroll
                    for (int n = 0; n < 2; ++n) pre[ai][bj][m][n] = *(const pg8::u32x2*)(x1 + off + bj * 128 + n * 16);
            }
    }
};
__global__ void __launch_bounds__(NTHR, 2) fwd_megakernel(Params p) {
    extern __shared__ __attribute__((aligned(16))) unsigned char lds_raw[];
    LAS unsigned char* lds = (LAS unsigned char*)lds_raw;
    cg::grid_group grid = cg::this_grid();
    const int G = gridDim.x, bx = blockIdx.x;
    const int wave_s = __builtin_amdgcn_readfirstlane((int)threadIdx.x >> 6);
#define FRESH_TID() (wave_s * 64 + lane_fresh())
    const int vcu = (G % 8 == 0) ? (bx % 8) * (G / 8) + bx / 8 : bx;
    unsigned char* ws = p.ws;
    const int lo = p.ph_lo, hi = p.ph_hi;
#define IN(k) (lo <= (k) && (k) < hi)
#define SEAM(k) do { if (IN(k) && IN((k) + 1)) { if ((k) == 0 && p.ph_hi == 0x7fffffff) grid.sync();   xcd_barrier(xbar, FRESH_TID() == 0); } } while (0)
    { const int t_ = FRESH_TID(); if (t_ < 2) ((volatile LAS unsigned*)(lds + 131072 + 8192))[t_] = 0u; }
    __syncthreads();
    XcdBarrier xbar; xbar.bar = (unsigned*)(ws + WS_CTL); xbar.x = 0; xbar.st = nullptr;
    if (hi - lo > 2) xbar = xcd_barrier_post((unsigned*)(ws + WS_CTL), (volatile LAS unsigned*)(lds + 131072 + 8192), FRESH_TID() == 0);
    bf16_t* H = (bf16_t*)(ws + WS_H);
    float* ropeA = (float*)(ws + WS_ROPEA); float* ropeB = (float*)(ws + WS_ROPEB);
    float* ssq_q = (float*)(ws + WS_SSQQ); float* ssq_x1 = (float*)(ws + WS_SSQX);
    bf16_t* CQ = (bf16_t*)(ws + WS_CQ); bf16_t* CKV = (bf16_t*)(ws + WS_CKV); bf16_t* Qa = (bf16_t*)(ws + WS_QA); bf16_t* Ka = (bf16_t*)(ws + WS_KA); bf16_t* Kpe = (bf16_t*)(ws + WS_KA + 16 * MiB); bf16_t* Vta = (bf16_t*)(ws + WS_VTA);
    bf16_t* Qd = (bf16_t*)(ws + WS_QD); bf16_t* Kd = (bf16_t*)(ws + WS_KD); bf16_t* Vtd = (bf16_t*)(ws + WS_VTD); bf16_t* O = (bf16_t*)(ws + WS_O);
    bf16_t* Abuf = (bf16_t*)(ws + WS_ABUF); float* HL = (float*)(ws + WS_HL);

#ifdef PROBE_PHASE
    unsigned long long pt0_ = 0;
#define PB(k) do { if ((k) == PROBE_PHASE) pt0_ = __builtin_amdgcn_s_memrealtime(); } while (0)
#define PE(k) do { if ((k) == PROBE_PHASE) { const unsigned long long t1_ = __builtin_amdgcn_s_memrealtime(); while (__builtin_amdgcn_s_memrealtime() - t1_ < t1_ - pt0_) __builtin_amdgcn_s_sleep(8); } } while (0)
#else
#define PB(k) do {} while (0)
#define PE(k) do {} while (0)
#endif
    PB(0);
    if (IN(0) && !SKIP0) for (int rep_ = 0; rep_ < REP0; ++rep_) { int t0_ = FRESH_TID(); asm volatile("" : "+v"(t0_)); p0_prologue(p, lds, vcu, G, __builtin_amdgcn_readfirstlane(t0_ >> 6), t0_ & 63); }
    SEAM(0);
    PE(0); PB(1);
    if (IN(1) && !SKIP1) for (int rep_ = 0; rep_ < REP1; ++rep_) {
        { pg8::Gemm g{H, (const bf16_t*)(ws + WS_WIN), M, 1792, 1024}; pg8::StaticOrder S; S.init(M, 1792, G, bx);
          pg8::EpiInProj E{CQ, CKV, Kpe, Qd, Kd, ssq_q, p.in[8], p.in[9], p.in[10], ropeA, ropeB, QSCALE_D, (LAS float*)(lds + 131072), (unsigned*)(ws + WS_CTL + 16384), (unsigned*)(ws + WS_CTL + 16384 + 64 * 256)};
          pg8::gemm_phase<pg8::EpiInProj, pg8::StaticOrder, true, true>(lds, g, S, E, wave_s); }
        { pg8::Gemm g{(const bf16_t*)(ws + WS_WDV), H, 512, M, 1024}; pg8::StaticOrder S; S.init(512, M, G, (bx + G - G / 2) % G);
          pg8::EpiStoreT E{Vtd, M};
          pg8::gemm_phase<pg8::EpiStoreT, pg8::StaticOrder, true, true>(lds, g, S, E, wave_s); }
    }
    if (IN(1) && !SKIP2) {
        unsigned* cntq = (unsigned*)(ws + WS_CTL + 16384); unsigned* cntkv = (unsigned*)(ws + WS_CTL + 16384 + 64 * 256);
#define PANEL_WAIT(cnt, pan, want) do { unsigned sp_ = 0; while (__hip_atomic_load((cnt) + 64 * (pan), __ATOMIC_RELAXED, __HIP_MEMORY_SCOPE_AGENT) < (want)) { __builtin_amdgcn_s_sleep(2); if (++sp_ > (1u << 22)) break; } \
        __builtin_amdgcn_fence(__ATOMIC_ACQUIRE, "workgroup"); asm volatile("" ::: "memory"); } while (0)
        { pg8::Gemm g{CQ, (const bf16_t*)(ws + WS_WQ), M, 768, 384}; pg8::StaticOrder S; S.init(M, 768, G, (bx + G / 4) % G);
          pg8::Unit u0; if (S.next(0, u0)) PANEL_WAIT(cntq, u0.pm, 16u);
          pg8::EpiQUp E{Qa, ssq_q, p.in[7], ropeA, QSCALE_A};
          pg8::gemm_phase<pg8::EpiQUp, pg8::StaticOrder, true, true>(lds, g, S, E, wave_s); }
        { pg8::Gemm g{CKV, (const bf16_t*)(ws + WS_WK), M, 512, 256}; pg8::StaticOrder S; S.init(M, 512, G, bx);
          pg8::Unit u0; if (S.next(0, u0)) PANEL_WAIT(cntkv, u0.pm, 8u);
          pg8::EpiKUp E{Ka, p.in[8]};
          pg8::gemm_phase<pg8::EpiKUp, pg8::StaticOrder, true, true>(lds, g, S, E, wave_s); }
        { pg8::Gemm g{(const bf16_t*)(ws + WS_WV), CKV, 512, M, 256}; pg8::StaticOrder S; S.init(512, M, G, (bx + G / 4) % G);
          pg8::Unit u0; if (S.next(0, u0)) PANEL_WAIT(cntkv, u0.pn, 8u);
          pg8::EpiStoreT E{Vta, M};
          pg8::gemm_phase<pg8::EpiStoreT, pg8::StaticOrder, true, true>(lds, g, S, E, wave_s); }
#undef PANEL_WAIT
        if (G == 256 && bx >= 64) { int t1_ = FRESH_TID(); asm volatile("" : "+v"(t1_)); const int w1_ = __builtin_amdgcn_readfirstlane(t1_ >> 6);
            convert_items(p, lds, CONV_EARLY, CONV_ALL - 44 * 32, (bx - 64) * NWAVES + w1_, 192 * NWAVES, w1_, t1_ & 63); }
    }
    do { if (IN(1) && IN(3)) { xcd_barrier(xbar, FRESH_TID() == 0); } } while (0);
    PE(1); PB(3);
    if (IN(3) && !SKIP3) for (int rep_ = 0; rep_ < REP3; ++rep_) {
        int t3_ = FRESH_TID(); asm volatile("" : "+v"(t3_)); const int lane = t3_ & 63;
        const float d1 = wave_sum(p.in[11][lane] * p.in[12][lane]), d2 = wave_sum(p.in[13][lane] * p.in[14][lane]);
        const float lam = __expf(d1) - __expf(d2) + 0.2f;
        if (rep_ == 0 && G != 256) {
            int t3b_ = FRESH_TID(); asm volatile("" : "+v"(t3b_)); const int w3_ = __builtin_amdgcn_readfirstlane(t3b_ >> 6);
            convert_items(p, lds, CONV_EARLY, (G == 256) ? CONV_ALL - 44 * 32 : CONV_ALL, vcu * NWAVES + w3_, G * NWAVES, w3_, t3b_ & 63);
            __syncthreads();
        }
        AttnP P{Qa, Ka, Kpe, Vta, Qd, Kd, Vtd, O, p.in[15]};
#ifdef ATT_VAR
        const int avar = (rep_ == 0) ? ATT_VAR : 0;
#else
        const int avar = 0;
#endif
        for (int su = vcu; su < 256; su += G) {
            { const int bh = su >> 2, s = su & 3; attn_unit<false>(lds, P, bh >> 3, bh & 7, 7 - s, 0.f, wave_s, avar); attn_unit<false>(lds, P, bh >> 3, bh & 7, s, 0.f, wave_s, avar); }
            { const int bh = su >> 3, s = su & 7; attn_unit<true>(lds, P, bh >> 2, bh & 3, 15 - s, lam, wave_s, avar); attn_unit<true>(lds, P, bh >> 2, bh & 3, s, lam, wave_s, avar); }
        }
    }
    pg8::f32x4 prex[2][2][4][2];
    bool have_prex = false;
    if (IN(3) && IN(4)) {
        pg8::StaticOrder S4; S4.init(M, 1024, G, bx); pg8::Unit u4; have_prex = S4.next(0, u4);
        if (have_prex) { PreloadX hook{p.in[0], u4, wave_s, prex}; xcd_barrier_preload(xbar, FRESH_TID() == 0, wave_s == 0, hook); }
        else xcd_barrier(xbar, FRESH_TID() == 0);
    }
    PE(3); PB(4);
#ifdef EXTRA_BAR
    xcd_barrier(xbar, FRESH_TID() == 0); xcd_barrier(xbar, FRESH_TID() == 0); xcd_barrier(xbar, FRESH_TID() == 0); xcd_barrier(xbar, FRESH_TID() == 0);
#endif
    if (IN(4) && !SKIP4) for (int rep_ = 0; rep_ < REP4; ++rep_) {
        pg8::Gemm g{O, (const bf16_t*)(ws + WS_WO), M, 1024, 1024}; pg8::StaticOrder S; S.init(M, 1024, G, bx);
        pg8::EpiWOut E{p.in[0], p.out, H, ssq_x1, prex, have_prex};
        pg8::gemm_phase<pg8::EpiWOut, pg8::StaticOrder, false, true>(lds, g, S, E, wave_s);
    }
    SEAM(4);
    PE(4); PB(5);
    if (IN(5) && !SKIP5) for (int rep_ = 0; rep_ < REP5; ++rep_) {
        pg8::Gemm g{H, (const bf16_t*)(ws + WS_WGU), M, 2 * FF, 1024}; pg8::StaticOrder S; S.init(M, 2 * FF, G, bx);
        pg8::EpiGateUp E{Abuf, HL, ssq_x1, p.in[20], p.in[21]};
        pg8::gemm_phase<pg8::EpiGateUp, pg8::StaticOrder, true, true>(lds, g, S, E, wave_s);
        if (G == 256 && bx >= 128 && rep_ == 0) {
            int t5_ = FRESH_TID(); asm volatile("" : "+v"(t5_)); const int w5_ = __builtin_amdgcn_readfirstlane(t5_ >> 6);
            convert_items(p, lds, CONV_ALL - 44 * 32, CONV_ALL, (bx - 128) * NWAVES + w5_, 128 * NWAVES, w5_, t5_ & 63);
        }
    }
    SEAM(5);
    PE(5); PB(6);
    if (IN(6) && !SKIP6) {
        const float* cw = p.in[20]; const float* cb = p.in[21];
        int tid = FRESH_TID(); asm volatile("" : "+v"(tid));
        for (int i = bx * NTHR + tid; i < 256 * 2 * (FF / 4); i += G * NTHR) {
            const int f = (i % (FF / 4)) * 4, rr = (i / (FF / 4)) & 1, kb = i / (2 * (FF / 4));
            const bool first = (kb & 31) == 0;
            const f32x4 z = (f32x4){0.f, 0.f, 0.f, 0.f};
            const f32x4 gt = *(const f32x4*)(HL + ((size_t)kb * 6 + 2 + rr) * FF + f), ut = *(const f32x4*)(HL + ((size_t)kb * 6 + 4 + rr) * FF + f);
            const f32x4 p63 = first ? z : *(const f32x4*)(HL + ((size_t)(kb - 1) * 6 + 1) * FF + f);
            f32x4 gm1, gm2;
            if (rr == 0) { gm1 = p63; gm2 = first ? z : *(const f32x4*)(HL + ((size_t)(kb - 1) * 6 + 0) * FF + f); }
            else { gm1 = *(const f32x4*)(HL + ((size_t)kb * 6 + 2) * FF + f); gm2 = p63; }
            const f32x4 w0 = *(const f32x4*)(cw + f), w1 = *(const f32x4*)(cw + FF + f), w2 = *(const f32x4*)(cw + 2 * FF + f), b4 = *(const f32x4*)(cb + f);
            f32x4 o;
#pragma unroll
            for (int j = 0; j < 4; ++j) { const float cv = w2[j] * gt[j] + w1[j] * gm1[j] + w0[j] * gm2[j] + b4[j]; o[j] = cv / (1.f + __expf(-cv)) * ut[j]; }
            pg8::store8(Abuf + (size_t)(kb * 64 + rr) * FF + f, pg8::pack4(o));
        }
    }
    pg8::u32x2 prew[2][2][4][2];
    bool have_prew = false;
    if (IN(6) && IN(7)) {
        pg8::StaticOrder S7; S7.init(M, 1024, G, bx); pg8::Unit u7; have_prew = S7.next(0, u7);
        if (have_prew) { PreloadX1 hook{H, u7, wave_s, prew}; xcd_barrier_preload(xbar, FRESH_TID() == 0, wave_s == 0, hook); }
        else xcd_barrier(xbar, FRESH_TID() == 0);
    }
    PE(6); PB(7);
    if (IN(7) && !SKIP7) {
        pg8::Gemm g{Abuf, (const bf16_t*)(ws + WS_WD), M, 1024, FF}; pg8::StaticOrder S; S.init(M, 1024, G, bx);
#ifdef REP7
        { pg8::EpiDown E0{H, (float*)(ws + WS_QD), prew, false}; pg8::gemm_phase<pg8::EpiDown, pg8::StaticOrder, false, true>(lds, g, S, E0, wave_s); }
#endif
        pg8::EpiDown E{H, p.out, prew, have_prew};
        pg8::gemm_phase<pg8::EpiDown, pg8::StaticOrder, false, true>(lds, g, S, E, wave_s);
    }
    PE(7);
#undef IN
#undef SEAM
}

#ifndef MK_N_LAUNCHES
#define MK_N_LAUNCHES 1
#endif
extern "C" void kernel_launch(void* const* d_in, const int* in_sizes, int n_in, void* d_out, int out_size, void* d_ws, size_t ws_size, hipStream_t stream) {
    static int grid = 0;
    if (grid == 0) {
        int dev = 0, cus = 0, per_cu = 0;
        hipGetDevice(&dev); hipDeviceGetAttribute(&cus, hipDeviceAttributeMultiprocessorCount, dev);
        hipFuncSetAttribute((const void*)fwd_megakernel, hipFuncAttributeMaxDynamicSharedMemorySize, LDS_BYTES);
        hipOccupancyMaxActiveBlocksPerMultiprocessor(&per_cu, (const void*)fwd_megakernel, NTHR, LDS_BYTES);
        (void)hipGetLastError();
        if (per_cu < 1) per_cu = 1;
        grid = cus * 1;
        if (grid <= 0) grid = 256;
    }
    Params p{};
    for (int i = 0; i < 23; ++i) p.in[i] = (const float*)d_in[i];
    p.out = (float*)d_out; p.ws = (unsigned char*)d_ws;
    for (int i = 0; i < 16; ++i) p.invA[i] = 1.0f / powf(10000.0f, (float)(2 * i) / 32.0f);
    for (int i = 0; i < 32; ++i) p.invB[i] = 1.0f / powf(10000.0f, (float)(2 * i) / 64.0f);
#if MK_N_LAUNCHES == 1
    p.ph_lo = 0; p.ph_hi = 8;
    hipMemsetAsync((char*)d_ws + WS_CTL, 0, CTL_BYTES, stream);
    void* args[] = {&p};
    hipError_t e = hipLaunchCooperativeKernel((const void*)fwd_megakernel, dim3(grid), dim3(NTHR), args, LDS_BYTES, stream);
    if (e != hipSuccess) fprintf(stderr, "cooperative launch failed: %s (grid %d)\n", hipGetErrorString(e), grid);
#else
    for (int ph = 0; ph < 8; ++ph) { p.ph_lo = ph; p.ph_hi = ph + 1; hipLaunchKernelGGL(fwd_megakernel, dim3(grid), dim3(NTHR), LDS_BYTES, stream, p); }
#endif
}
```
